# Optimizing an MI355X kernel written in HIP

```python
import math
import jax, jax.numpy as jnp
from jax import lax
import numpy as np

D_MODEL = 1024
BATCH = 8
SEQ = 2048
DEPTH = 1

RET_HEADS = 4
RET_HEAD_DIM = 128
RET_WIDTH = RET_HEADS * RET_HEAD_DIM
RET_CHUNK = 128
SWA_HEADS = 8
SWA_KV_HEADS = 2
SWA_GROUP = SWA_HEADS // SWA_KV_HEADS
SWA_HEAD_DIM = 64
SWA_WIDTH = SWA_HEADS * SWA_HEAD_DIM
SWA_KV_WIDTH = SWA_KV_HEADS * SWA_HEAD_DIM
WINDOW = 128
MIX_WIDTH = RET_WIDTH + SWA_WIDTH
IN_WIDTH = 4 * RET_WIDTH + SWA_WIDTH + 2 * SWA_KV_WIDTH
N_GROUPS = 4
EXPERTS_PER_GROUP = 8
N_EXPERTS = N_GROUPS * EXPERTS_PER_GROUP
TOP_K = 2
D_EXPERT = 512
MOE_BLOCK = 256
LN_EPS = 1e-5
GN_EPS = 1e-6
DEEPNORM_ALPHA = (2 * DEPTH) ** 0.25
DEEPNORM_BETA = (8 * DEPTH) ** -0.25

kernel_name = 'hymba_retention_swa_alibi_hmoe_deepnorm'


def layer_norm(x, g, b):
    xf = x.astype(jnp.float32)
    mu = xf.mean(-1, keepdims=True)
    var = jnp.square(xf - mu).mean(-1, keepdims=True)
    return ((xf - mu) * lax.rsqrt(var + LN_EPS) * g + b).astype(x.dtype)


def retention_chunkwise(q, k, v):
    bsz, nh, s_len, d = q.shape
    c = RET_CHUNK
    n = s_len // c
    log_g = jnp.log1p(-jnp.exp2(-5.0 - jnp.arange(nh, dtype=jnp.float32)))
    idx = jnp.arange(c, dtype=jnp.float32)
    diff = idx[:, None] - idx[None, :]
    decay_in = jnp.where(diff >= 0, jnp.exp(log_g[:, None, None] * jnp.maximum(diff, 0.0)), 0.0)
    q_decay = jnp.exp(log_g[:, None] * (idx + 1.0))
    k_decay = jnp.exp(log_g[:, None] * (c - 1.0 - idx))
    chunk_decay = jnp.exp(log_g * c)
    qc = q.reshape(bsz, nh, n, c, d)
    kc = k.reshape(bsz, nh, n, c, d)
    vc = v.reshape(bsz, nh, n, c, d)
    scores = jnp.einsum('bhncd,bhnmd->bhncm', qc, kc) * decay_in[None, :, None]
    inner = jnp.einsum('bhncm,bhnme->bhnce', scores, vc)
    kv = jnp.einsum('bhnmd,bhnme->nbhde', kc * k_decay[None, :, None, :, None], vc)

    def step(state, kv_n):
        return state * chunk_decay[None, :, None, None] + kv_n, state

    _, states = lax.scan(step, jnp.zeros_like(kv[0]), kv)
    cross = jnp.einsum('bhncd,nbhde->bhnce', qc * q_decay[None, :, None, :, None], states)
    return (inner + cross).reshape(bsz, nh, s_len, d)


def sliding_window_gqa(q, k, v, sinks):
    bsz, s_len = q.shape[:2]
    w = WINDOW
    n = s_len // w
    qb = q.reshape(bsz, n, w, SWA_KV_HEADS, SWA_GROUP, SWA_HEAD_DIM)
    pad = ((0, 0), (w, 0), (0, 0), (0, 0))
    kp = jnp.pad(k, pad).reshape(bsz, n + 1, w, SWA_KV_HEADS, SWA_HEAD_DIM)
    vp = jnp.pad(v, pad).reshape(bsz, n + 1, w, SWA_KV_HEADS, SWA_HEAD_DIM)
    kb = jnp.concatenate([kp[:, :-1], kp[:, 1:]], axis=2)
    vb = jnp.concatenate([vp[:, :-1], vp[:, 1:]], axis=2)
    s = jnp.einsum('bnqkgd,bnskd->bnkgqs', qb, kb,
                   preferred_element_type=jnp.float32) * (SWA_HEAD_DIM ** -0.5)
    qpos = jnp.arange(w)[:, None]
    kpos = jnp.arange(2 * w)[None, :] - w
    dist = qpos - kpos
    abs_k = jnp.arange(n)[:, None, None] * w + kpos[None]
    valid = (dist >= 0) & (dist < w) & (abs_k >= 0)
    slopes = jnp.exp2(-8.0 * (jnp.arange(SWA_HEADS, dtype=jnp.float32) + 1.0) / SWA_HEADS)
    slopes = slopes.reshape(SWA_KV_HEADS, SWA_GROUP)[:, :, None, None]
    s = s - slopes * dist.astype(jnp.float32)
    s = jnp.where(valid[None, :, None, None], s, -jnp.inf)
    sink = sinks.astype(jnp.float32).reshape(SWA_KV_HEADS, SWA_GROUP)[:, :, None, None]
    m = jnp.maximum(s.max(-1, keepdims=True), sink)
    p = jnp.exp(s - m)
    p = p / (p.sum(-1, keepdims=True) + jnp.exp(sink - m))
    o = jnp.einsum('bnkgqs,bnskd->bnqkgd', p, vb.astype(jnp.float32))
    return o.reshape(bsz, s_len, SWA_WIDTH).astype(q.dtype)


def hybrid_mixer(x, w_in, ret_gn_g, attn_sinks, w_out):
    bsz, s_len, _ = x.shape
    proj = jnp.einsum('bsd,de->bse', x, w_in)
    splits = [RET_WIDTH, 2 * RET_WIDTH, 3 * RET_WIDTH, 4 * RET_WIDTH,
              4 * RET_WIDTH + SWA_WIDTH, 4 * RET_WIDTH + SWA_WIDTH + SWA_KV_WIDTH]
    q_r, k_r, v_r, g_r, q_a, k_a, v_a = jnp.split(proj, splits, axis=-1)

    def heads(t):
        return t.reshape(bsz, s_len, RET_HEADS, RET_HEAD_DIM).transpose(0, 2, 1, 3).astype(jnp.float32)
    o_r = retention_chunkwise(heads(q_r), heads(k_r) * (RET_HEAD_DIM ** -0.5), heads(v_r))
    mu = o_r.mean(-1, keepdims=True)
    var = jnp.square(o_r - mu).mean(-1, keepdims=True)
    o_r = ((o_r - mu) * lax.rsqrt(var + GN_EPS)).transpose(0, 2, 1, 3).reshape(bsz, s_len, RET_WIDTH)
    o_r = (o_r * ret_gn_g).astype(x.dtype) * jax.nn.silu(g_r)

    o_a = sliding_window_gqa(
        q_a.reshape(bsz, s_len, SWA_KV_HEADS, SWA_GROUP, SWA_HEAD_DIM),
        k_a.reshape(bsz, s_len, SWA_KV_HEADS, SWA_HEAD_DIM),
        v_a.reshape(bsz, s_len, SWA_KV_HEADS, SWA_HEAD_DIM),
        attn_sinks)

    o = jnp.concatenate([o_r, o_a.astype(x.dtype)], axis=-1)
    return jnp.einsum('bse,ed->bsd', o, w_out)


def hierarchical_moe(h, w_group_router, b_group_router, w_expert_router, b_expert_router,
                     w_gate, w_up, w_down):
    t_len, d = h.shape
    gl = (h @ w_group_router + b_group_router).astype(jnp.float32)
    gp = jax.nn.softmax(gl, axis=-1)
    g_idx = jnp.argmax(gl, axis=-1)
    g_w = jnp.take_along_axis(gp, g_idx[:, None], axis=-1)
    el = jnp.einsum('td,gde->tge', h, w_expert_router) + b_expert_router
    el = jnp.take_along_axis(el, g_idx[:, None, None], axis=1)[:, 0].astype(jnp.float32)
    top_l, top_i = lax.top_k(el, TOP_K)
    e_w = jax.nn.softmax(top_l, axis=-1) * g_w
    e_id = g_idx[:, None] * EXPERTS_PER_GROUP + top_i

    flat_e = e_id.reshape(-1)
    flat_w = e_w.reshape(-1)
    flat_tok = jnp.repeat(jnp.arange(t_len), TOP_K)
    order = jnp.argsort(flat_e)
    e_s = flat_e[order]
    tok_s = flat_tok[order]
    w_s = flat_w[order]
    counts = jnp.bincount(flat_e, length=N_EXPERTS)
    padded = (counts + MOE_BLOCK - 1) // MOE_BLOCK * MOE_BLOCK
    start = jnp.cumsum(counts) - counts
    pend = jnp.cumsum(padded)
    pstart = pend - padded
    dest = pstart[e_s] + (jnp.arange(t_len * TOP_K) - start[e_s])
    n_blocks = -(-(t_len * TOP_K) // MOE_BLOCK) + N_EXPERTS
    n_rows = n_blocks * MOE_BLOCK
    rows = jnp.zeros((n_rows, d), h.dtype).at[dest].set(h[tok_s])
    block_expert = jnp.searchsorted(pend, jnp.arange(n_blocks) * MOE_BLOCK, side='right')
    block_expert = jnp.minimum(block_expert, N_EXPERTS - 1)

    def expert_block(args):
        xb, e = args
        return (jax.nn.silu(xb @ w_gate[e]) * (xb @ w_up[e])) @ w_down[e]

    y_rows = lax.map(expert_block, (rows.reshape(n_blocks, MOE_BLOCK, d), block_expert))
    y_rows = y_rows.reshape(n_rows, d)
    return jnp.zeros((t_len, d), h.dtype).at[tok_s].add(y_rows[dest] * w_s[:, None].astype(h.dtype))


def setup_inputs(seed: int = 0) -> dict:
    key = jax.random.key(seed)
    ks = jax.random.split(key, 16)
    f32 = jnp.float32

    def normal(k, shape, scale):
        return jax.random.normal(k, shape, f32) * scale

    col_scale = jnp.concatenate([
        jnp.ones((2 * RET_WIDTH,), f32),
        jnp.full((RET_WIDTH,), DEEPNORM_BETA, f32),
        jnp.ones((RET_WIDTH + SWA_WIDTH + SWA_KV_WIDTH,), f32),
        jnp.full((SWA_KV_WIDTH,), DEEPNORM_BETA, f32)])
    x = normal(ks[0], (BATCH, SEQ, D_MODEL), 1.0)
    w_in = normal(ks[1], (DEPTH, D_MODEL, IN_WIDTH), D_MODEL ** -0.5) * col_scale
    ret_gn_g = 1.0 + normal(ks[2], (DEPTH, RET_WIDTH), 0.02)
    attn_sinks = normal(ks[3], (DEPTH, SWA_HEADS), 0.5)
    w_out = normal(ks[4], (DEPTH, MIX_WIDTH, D_MODEL), MIX_WIDTH ** -0.5 * DEEPNORM_BETA)
    ln1_g = 1.0 + normal(ks[5], (DEPTH, D_MODEL), 0.02)
    ln1_b = normal(ks[6], (DEPTH, D_MODEL), 0.02)
    w_group_router = normal(ks[7], (DEPTH, D_MODEL, N_GROUPS), D_MODEL ** -0.5)
    b_group_router = normal(ks[8], (DEPTH, N_GROUPS), 0.01)
    w_expert_router = normal(ks[9], (DEPTH, N_GROUPS, D_MODEL, EXPERTS_PER_GROUP), D_MODEL ** -0.5)
    b_expert_router = normal(ks[10], (DEPTH, N_GROUPS, EXPERTS_PER_GROUP), 0.01)
    w_gate = normal(ks[11], (DEPTH, N_EXPERTS, D_MODEL, D_EXPERT), D_MODEL ** -0.5 * DEEPNORM_BETA)
    w_up = normal(ks[12], (DEPTH, N_EXPERTS, D_MODEL, D_EXPERT), D_MODEL ** -0.5 * DEEPNORM_BETA)
    w_down = normal(ks[13], (DEPTH, N_EXPERTS, D_EXPERT, D_MODEL), D_EXPERT ** -0.5 * DEEPNORM_BETA)
    ln2_g = 1.0 + normal(ks[14], (DEPTH, D_MODEL), 0.02)
    ln2_b = normal(ks[15], (DEPTH, D_MODEL), 0.02)
    return {'x': x, 'w_in': w_in, 'ret_gn_g': ret_gn_g, 'attn_sinks': attn_sinks,
            'w_out': w_out, 'ln1_g': ln1_g, 'ln1_b': ln1_b,
            'w_group_router': w_group_router, 'b_group_router': b_group_router,
            'w_expert_router': w_expert_router, 'b_expert_router': b_expert_router,
            'w_gate': w_gate, 'w_up': w_up, 'w_down': w_down,
            'ln2_g': ln2_g, 'ln2_b': ln2_b}


def reference(x, w_in, ret_gn_g, attn_sinks, w_out, ln1_g, ln1_b,
              w_group_router, b_group_router, w_expert_router, b_expert_router,
              w_gate, w_up, w_down, ln2_g, ln2_b):
    bsz, s_len, d = x.shape
    for i in range(DEPTH):
        mix = hybrid_mixer(x, w_in[i], ret_gn_g[i], attn_sinks[i], w_out[i])
        x = layer_norm(DEEPNORM_ALPHA * x + mix, ln1_g[i], ln1_b[i])
        ffn = hierarchical_moe(x.reshape(bsz * s_len, d), w_group_router[i], b_group_router[i],
                               w_expert_router[i], b_expert_router[i],
                               w_gate[i], w_up[i], w_down[i]).reshape(bsz, s_len, d)
        x = layer_norm(DEEPNORM_ALPHA * x + ffn, ln2_g[i], ln2_b[i])
    return x
```

```cpp
#include <hip/hip_runtime.h>
#include <cstdio>
#include <cstdint>

typedef unsigned short bf16_t;
typedef float f32x4 __attribute__((ext_vector_type(4)));
typedef unsigned u32x4 __attribute__((ext_vector_type(4)));
typedef unsigned u32x2 __attribute__((ext_vector_type(2)));

constexpr int BATCH = 8, SEQ = 2048, D = 1024, T = BATCH * SEQ;
constexpr int RET_H = 4, RET_D = 128, RET_W = 512, CH = 128, NCH = SEQ / CH;
constexpr int SWA_H = 8, SWA_KV = 2, SWA_G = 4, SWA_D = 64, SWA_W = 512, SWA_KVW = 128, WIN = 128;
constexpr int INW = 2816;
constexpr int C_QR = 0, C_KR = 512, C_VR = 1024, C_GR = 1536, C_QA = 2048, C_KA = 2560, C_VA = 2688;
constexpr int NG = 4, EPG = 8, NE = 32, DE = 512;
constexpr float LN_EPS = 1e-5f, GN_EPS = 1e-6f;
constexpr float ALPHA = 1.189207115002721f;
constexpr float LOG2E = 1.4426950408889634f;
constexpr float QA_SCALE = 0.125f * LOG2E;
constexpr float KR_SCALE = 0.08838834764831845f;

constexpr size_t MiB = 1u << 20;
constexpr size_t WS_CTL = 0, CTL_BYTES = 64 * 1024;
constexpr size_t WS_WI = 1 * MiB;
constexpr size_t WS_WO = 7 * MiB;
constexpr size_t WS_WGU = 9 * MiB;
constexpr size_t WS_WD = 73 * MiB;
constexpr size_t WS_XB = 105 * MiB;
constexpr size_t WS_PROJ = 137 * MiB;
constexpr size_t WS_YS = 177 * MiB;
constexpr size_t WS_LIST = 257 * MiB;
constexpr size_t WS_TOK = 261 * MiB;
constexpr size_t WS_RW = 262 * MiB;
constexpr size_t WS_END = 263 * MiB;
constexpr int LIST_CAP = 2 * T;
constexpr int MAX_SLOTS = 2 * T + NE * 256;
constexpr int CW_CNT = 0;

__device__ __forceinline__ float bf2f(bf16_t b) { return __builtin_bit_cast(float, (unsigned)b << 16); }
__device__ __forceinline__ bf16_t f2bf(float f) { unsigned u = __builtin_bit_cast(unsigned, f); return (bf16_t)((u + 0x7fffu + ((u >> 16) & 1u)) >> 16); }
__device__ __forceinline__ unsigned pk2(float lo, float hi) { return (unsigned)f2bf(lo) | ((unsigned)f2bf(hi) << 16); }
__device__ __forceinline__ float wave_sum(float v) {
#pragma unroll
    for (int o = 1; o < 64; o <<= 1) v += __shfl_xor(v, o);
    return v;
}
__device__ __forceinline__ float log2gamma(int h) { return log2f(1.0f - exp2f(-5.0f - (float)h)); }
__device__ __forceinline__ float siluf(float v) { return v / (1.0f + __expf(-v)); }

__device__ __forceinline__ float proj_scale(int row, int col) {
    const int i = row & (CH - 1);
    if (col < C_KR) { const int h = col >> 7; return exp2f(log2gamma(h) * (float)(i + 1)); }
    if (col < C_VR) { const int h = (col - C_KR) >> 7; return KR_SCALE * exp2f(log2gamma(h) * (float)(CH - 1 - i)); }
    if (col >= C_QA && col < C_KA) return QA_SCALE;
    return 1.0f;
}

__global__ void __launch_bounds__(256) k_transpose(const float* __restrict__ W, int K, int N, bf16_t* __restrict__ Wt, int kind, size_t src_stride, size_t dst_row_stride, int nmat) {
    __shared__ float tile[64][65];
    const int nb = N / 64, kb = K / 64;
    const int per = nb * kb;
    for (int it = blockIdx.x; it < per * nmat; it += gridDim.x) {
        const int mat = it / per, r = it % per, k0 = (r / nb) * 64, n0 = (r % nb) * 64;
        const float* Ws = W + (size_t)mat * src_stride;
        __syncthreads();
        for (int i = threadIdx.x; i < 64 * 64; i += 256) { const int kk = i >> 6, nn = i & 63; tile[kk][nn] = Ws[(size_t)(k0 + kk) * N + n0 + nn]; }
        __syncthreads();
        for (int i = threadIdx.x; i < 64 * 32; i += 256) { const int nn = i >> 5, kk = (i & 31) * 2; const int n = n0 + nn;
            int row = (kind == 0) ? n : ((n >> 7) * 256 + (kind - 1) * 128 + (n & 127));
            size_t drow = (size_t)mat * dst_row_stride + row;
            *(unsigned*)(Wt + drow * K + k0 + kk) = pk2(tile[kk][nn], tile[kk + 1][nn]); }
    }
}
__global__ void __launch_bounds__(256) k_convert_x(const float* __restrict__ x, bf16_t* __restrict__ xb, size_t n4) {
    for (size_t i = (size_t)blockIdx.x * 256 + threadIdx.x; i < n4; i += (size_t)gridDim.x * 256) {
        const f32x4 v = ((const f32x4*)x)[i]; u32x2 o; o.x = pk2(v.x, v.y); o.y = pk2(v.z, v.w); ((u32x2*)xb)[i] = o; }
}
__global__ void __launch_bounds__(256) k_router_w(const float* __restrict__ wgr, const float* __restrict__ bgr, const float* __restrict__ wer, const float* __restrict__ ber, float* __restrict__ rw) {
    for (int i = blockIdx.x * 256 + threadIdx.x; i < 36 * D; i += gridDim.x * 256) {
        const int c = i / D, k = i % D;
        rw[i] = (c < 4) ? wgr[k * NG + c] : wer[((size_t)((c - 4) >> 3) * D + k) * EPG + ((c - 4) & 7)];
    }
    if (blockIdx.x == 0 && threadIdx.x < 36) rw[36 * D + threadIdx.x] = threadIdx.x < 4 ? bgr[threadIdx.x] : ber[threadIdx.x - 4];
}

struct NUnit { const bf16_t* Bt; int valid; };
template <class Epi, class Rows>
__global__ void __launch_bounds__(256) k_ngemm(int N, int K, Epi epi, Rows rows) {
    __shared__ float As[64][33], Bs[64][33];
    const int tm = blockIdx.x, tn = blockIdx.y;
    const bf16_t* Bt; if (!rows.tile(tm, Bt)) return;
    const int tx = threadIdx.x & 15, ty = threadIdx.x >> 4;
    float acc[4][4];
#pragma unroll
    for (int i = 0; i < 4; ++i)
#pragma unroll
        for (int j = 0; j < 4; ++j) acc[i][j] = 0.f;
    for (int k0 = 0; k0 < K; k0 += 32) {
        __syncthreads();
        for (int i = threadIdx.x; i < 64 * 16; i += 256) { const int r = i >> 4, kk = (i & 15) * 2;
            const bf16_t* ap = rows.arow(tm * 64 + r);
            unsigned av = ap ? *(const unsigned*)(ap + k0 + kk) : 0u;
            As[r][kk] = bf2f((bf16_t)(av & 0xffff)); As[r][kk + 1] = bf2f((bf16_t)(av >> 16));
            unsigned bv = *(const unsigned*)(Bt + (size_t)(tn * 64 + r) * K + k0 + kk);
            Bs[r][kk] = bf2f((bf16_t)(bv & 0xffff)); Bs[r][kk + 1] = bf2f((bf16_t)(bv >> 16)); }
        __syncthreads();
#pragma unroll 8
        for (int kk = 0; kk < 32; ++kk) {
            float a[4], b[4];
#pragma unroll
            for (int i = 0; i < 4; ++i) { a[i] = As[ty * 4 + i][kk]; b[i] = Bs[tx * 4 + i][kk]; }
#pragma unroll
            for (int i = 0; i < 4; ++i)
#pragma unroll
                for (int j = 0; j < 4; ++j) acc[i][j] += a[i] * b[j];
        }
    }
#pragma unroll
    for (int i = 0; i < 4; ++i)
#pragma unroll
        for (int j = 0; j < 4; ++j) epi(tm * 64 + ty * 4 + i, tn * 64 + tx * 4 + j, acc[i][j]);
}
struct RowsDense { const bf16_t* A; const bf16_t* B; int K; int pad;
    __device__ bool tile(int, const bf16_t*& Bt) const { Bt = B; return true; }
    __device__ const bf16_t* arow(int r) const { return A + (size_t)r * K; } };
struct EpiProj { bf16_t* P; __device__ void operator()(int r, int c, float v) const { P[(size_t)r * INW + c] = f2bf(v * proj_scale(r, c)); } };
struct EpiZ { const float* x; float* z; __device__ void operator()(int r, int c, float v) const { z[(size_t)r * D + c] = ALPHA * x[(size_t)r * D + c] + v; } };

struct MoeMap { int tile_base[NE + 1]; };
__device__ __forceinline__ void moe_map(const unsigned* cnt, int* tb  ) { int s = 0; for (int e = 0; e < NE; ++e) { tb[e] = s; s += ((int)cnt[e] + 255) >> 8; } tb[NE] = s; }
struct RowsMoe1 { const bf16_t* hb; const bf16_t* W; const unsigned* cnt; const int* list; size_t wstride;
    __device__ int find(int s, int& local) const { int base = 0; for (int e = 0; e < NE; ++e) { const int nt = ((int)cnt[e] + 255) >> 8; if (s < (base + nt) * 256) { local = s - base * 256; return e; } base += nt; } return -1; }
    __device__ bool tile(int tm, const bf16_t*& Bt) const { int l; const int e = find(tm * 64, l); if (e < 0) return false; Bt = W + (size_t)e * wstride; return true; }
    __device__ const bf16_t* arow(int s) const { int l; const int e = find(s, l); if (e < 0 || l >= (int)cnt[e]) return nullptr; return hb + (size_t)list[(size_t)e * LIST_CAP + l] * D; } };
struct RowsMoe2 { const bf16_t* act; const bf16_t* W; const unsigned* cnt; size_t wstride;
    __device__ int find(int s) const { int base = 0; for (int e = 0; e < NE; ++e) { const int nt = ((int)cnt[e] + 255) >> 8; if (s < (base + nt) * 256) return e; base += nt; } return -1; }
    __device__ bool tile(int tm, const bf16_t*& Bt) const { const int e = find(tm * 64); if (e < 0) return false; Bt = W + (size_t)e * wstride; return true; }
    __device__ const bf16_t* arow(int s) const { return act + (size_t)s * DE; } };
struct EpiGU { bf16_t* gu; __device__ void operator()(int r, int c, float v) const { gu[(size_t)r * 1024 + c] = f2bf(v); } };
__global__ void __launch_bounds__(256) k_act(const bf16_t* __restrict__ gu, bf16_t* __restrict__ act, const unsigned* __restrict__ cnt) {
    int nt = 0; for (int e = 0; e < NE; ++e) nt += ((int)cnt[e] + 255) >> 8;
    const size_t n = (size_t)nt * 256 * DE;
    for (size_t i = (size_t)blockIdx.x * 256 + threadIdx.x; i < n; i += (size_t)gridDim.x * 256) {
        const size_t s = i / DE; const int c = (int)(i % DE); const int pn = c >> 7, cc = c & 127;
        const float g = bf2f(gu[s * 1024 + pn * 256 + cc]), u = bf2f(gu[s * 1024 + pn * 256 + 128 + cc]);
        act[i] = f2bf(siluf(g) * u); }
}
struct EpiYs { bf16_t* ys; __device__ void operator()(int r, int c, float v) const { ys[(size_t)r * D + c] = f2bf(v); } };

__global__ void __launch_bounds__(256) k_nret(const bf16_t* __restrict__ proj, const float* __restrict__ gn_g, bf16_t* __restrict__ o) {
    const int lane = threadIdx.x & 63; const int gw = blockIdx.x * 4 + (threadIdx.x >> 6);
    if (gw >= T * RET_H) return;
    const int tok = gw / RET_H, h = gw % RET_H, b = tok / SEQ, t = tok % SEQ, n = t / CH;
    const float lg = log2gamma(h);
    const unsigned qv = *(const unsigned*)(proj + (size_t)tok * INW + C_QR + h * RET_D + 2 * lane);
    const float q0 = bf2f((bf16_t)(qv & 0xffff)), q1 = bf2f((bf16_t)(qv >> 16));
    float o0 = 0.f, o1 = 0.f;
    for (int s = 0; s <= t; ++s) {
        const size_t kr = (size_t)(b * SEQ + s) * INW;
        const unsigned kv = *(const unsigned*)(proj + kr + C_KR + h * RET_D + 2 * lane);
        float d = q0 * bf2f((bf16_t)(kv & 0xffff)) + q1 * bf2f((bf16_t)(kv >> 16));
        d = wave_sum(d);
        const int m = s / CH;
        const float c = exp2f(lg * (float)((n - m - 1) * CH));
        const float p = bf2f(f2bf(d * c));
        const unsigned vv = *(const unsigned*)(proj + kr + C_VR + h * RET_D + 2 * lane);
        o0 += p * bf2f((bf16_t)(vv & 0xffff)); o1 += p * bf2f((bf16_t)(vv >> 16));
    }
    const float mu = wave_sum(o0 + o1) * (1.f / RET_D);
    const float d0 = o0 - mu, d1 = o1 - mu;
    const float var = wave_sum(d0 * d0 + d1 * d1) * (1.f / RET_D);
    const float rs = 1.0f / sqrtf(var + GN_EPS);
    const unsigned gv = *(const unsigned*)(proj + (size_t)tok * INW + C_GR + h * RET_D + 2 * lane);
    const float g0 = bf2f((bf16_t)(gv & 0xffff)), g1 = bf2f((bf16_t)(gv >> 16));
    const float r0 = d0 * rs * gn_g[h * RET_D + 2 * lane] * siluf(g0), r1 = d1 * rs * gn_g[h * RET_D + 2 * lane + 1] * siluf(g1);
    *(unsigned*)(o + (size_t)tok * D + h * RET_D + 2 * lane) = pk2(r0, r1);
}
__global__ void __launch_bounds__(256) k_nswa(const bf16_t* __restrict__ proj, const float* __restrict__ sinks, bf16_t* __restrict__ o) {
    const int lane = threadIdx.x & 63; const int gw = blockIdx.x * 4 + (threadIdx.x >> 6);
    if (gw >= T * SWA_H) return;
    const int tok = gw / SWA_H, h = gw % SWA_H, kvh = h / SWA_G, b = tok / SEQ, t = tok % SEQ;
    const float slope2 = exp2f(-(float)(h + 1)) * LOG2E, sink2 = sinks[h] * LOG2E;
    const float q = bf2f(proj[(size_t)tok * INW + C_QA + h * SWA_D + lane]);
    float m = sink2, l = 0.f, acc = 0.f;
    const int s0 = t - (WIN - 1) < 0 ? 0 : t - (WIN - 1);
    for (int s = s0; s <= t; ++s) { const float d = wave_sum(q * bf2f(proj[(size_t)(b * SEQ + s) * INW + C_KA + kvh * SWA_D + lane])) - slope2 * (float)(t - s); m = fmaxf(m, d); }
    for (int s = s0; s <= t; ++s) { const size_t kr = (size_t)(b * SEQ + s) * INW;
        const float d = wave_sum(q * bf2f(proj[kr + C_KA + kvh * SWA_D + lane])) - slope2 * (float)(t - s);
        const float p = exp2f(d - m); l += p; acc += bf2f(f2bf(p)) * bf2f(proj[kr + C_VA + kvh * SWA_D + lane]); }
    l += exp2f(sink2 - m);
    o[(size_t)tok * D + RET_W + h * SWA_D + lane] = f2bf(acc / l);
}

__global__ void __launch_bounds__(256) k_route(const float* __restrict__ z, const float* __restrict__ g1, const float* __restrict__ b1, const float* __restrict__ rw,
                                               bf16_t* __restrict__ hb, unsigned* __restrict__ cnt, int* __restrict__ list, int* __restrict__ tok_e, int* __restrict__ tok_pos, float* __restrict__ tok_w) {
    const int lane = threadIdx.x & 63; const int tok = blockIdx.x * 4 + (threadIdx.x >> 6);
    if (tok >= T) return;
    f32x4 v[4]; float s = 0.f;
#pragma unroll
    for (int j = 0; j < 4; ++j) { v[j] = *(const f32x4*)(z + (size_t)tok * D + j * 256 + lane * 4); s += (v[j].x + v[j].y) + (v[j].z + v[j].w); }
    const float mean = wave_sum(s) * (1.f / D); float s2 = 0.f;
#pragma unroll
    for (int j = 0; j < 4; ++j) { v[j] = v[j] - mean; s2 += (v[j].x * v[j].x + v[j].y * v[j].y) + (v[j].z * v[j].z + v[j].w * v[j].w); }
    const float rstd = 1.0f / sqrtf(wave_sum(s2) * (1.f / D) + LN_EPS);
#pragma unroll
    for (int j = 0; j < 4; ++j) { const f32x4 g = *(const f32x4*)(g1 + j * 256 + lane * 4), bb = *(const f32x4*)(b1 + j * 256 + lane * 4);
        v[j] = v[j] * rstd * g + bb;
        u32x2 w; w.x = pk2(v[j].x, v[j].y); w.y = pk2(v[j].z, v[j].w); *(u32x2*)(hb + (size_t)tok * D + j * 256 + lane * 4) = w; }
    float lg0, lg1, lg2, lg3;
    { float a[4];
#pragma unroll
      for (int c = 0; c < 4; ++c) { float t = 0.f;
#pragma unroll
        for (int j = 0; j < 4; ++j) { const f32x4 w = *(const f32x4*)(rw + (size_t)c * D + j * 256 + lane * 4); t += v[j].x * w.x + v[j].y * w.y + v[j].z * w.z + v[j].w * w.w; }
        a[c] = wave_sum(t) + rw[36 * D + c]; }
      lg0 = a[0]; lg1 = a[1]; lg2 = a[2]; lg3 = a[3]; }
    int gi = 0; float gm = lg0;
    if (lg1 > gm) { gm = lg1; gi = 1; }
    if (lg2 > gm) { gm = lg2; gi = 2; }
    if (lg3 > gm) { gm = lg3; gi = 3; }
    const float gs = __expf(lg0 - gm) + __expf(lg1 - gm) + __expf(lg2 - gm) + __expf(lg3 - gm);
    const float gw = 1.0f / gs;
    float el[8];
#pragma unroll
    for (int e = 0; e < 8; ++e) { const int c = 4 + gi * 8 + e; float t = 0.f;
#pragma unroll
        for (int j = 0; j < 4; ++j) { const f32x4 w = *(const f32x4*)(rw + (size_t)c * D + j * 256 + lane * 4); t += v[j].x * w.x + v[j].y * w.y + v[j].z * w.z + v[j].w * w.w; }
        el[e] = wave_sum(t) + rw[36 * D + c]; }
    int i0 = 0; float l0 = el[0];
#pragma unroll
    for (int e = 1; e < 8; ++e) if (el[e] > l0) { l0 = el[e]; i0 = e; }
    int i1 = -1; float l1 = -INFINITY;
#pragma unroll
    for (int e = 0; e < 8; ++e) if (e != i0 && el[e] > l1) { l1 = el[e]; i1 = e; }
    const float e1 = __expf(l1 - l0); const float w0 = gw / (1.f + e1), w1 = gw * e1 / (1.f + e1);
    if (lane == 0) {
        const int e0 = gi * 8 + i0, e1i = gi * 8 + i1;
        const int p0 = (int)atomicAdd(&cnt[e0], 1u), p1 = (int)atomicAdd(&cnt[e1i], 1u);
        list[(size_t)e0 * LIST_CAP + p0] = tok; list[(size_t)e1i * LIST_CAP + p1] = tok;
        tok_e[tok * 2] = e0; tok_e[tok * 2 + 1] = e1i; tok_pos[tok * 2] = p0; tok_pos[tok * 2 + 1] = p1; tok_w[tok * 2] = w0; tok_w[tok * 2 + 1] = w1;
    }
}
__global__ void __launch_bounds__(256) k_final(const bf16_t* __restrict__ hb, const bf16_t* __restrict__ ys, const unsigned* __restrict__ cnt, const int* __restrict__ tok_e, const int* __restrict__ tok_pos,
                                               const float* __restrict__ tok_w, const float* __restrict__ g2, const float* __restrict__ b2, float* __restrict__ out) {
    const int lane = threadIdx.x & 63; const int tok = blockIdx.x * 4 + (threadIdx.x >> 6);
    if (tok >= T) return;
    int sl[2];
#pragma unroll
    for (int k = 0; k < 2; ++k) { const int e = tok_e[tok * 2 + k]; int base = 0; for (int q = 0; q < e; ++q) base += ((int)cnt[q] + 255) >> 8; sl[k] = base * 256 + tok_pos[tok * 2 + k]; }
    const float w0 = tok_w[tok * 2], w1 = tok_w[tok * 2 + 1];
    f32x4 v[4]; float s = 0.f;
#pragma unroll
    for (int j = 0; j < 4; ++j) { const int c = j * 256 + lane * 4;
        const u32x2 hv = *(const u32x2*)(hb + (size_t)tok * D + c), y0 = *(const u32x2*)(ys + (size_t)sl[0] * D + c), y1 = *(const u32x2*)(ys + (size_t)sl[1] * D + c);
        v[j].x = ALPHA * bf2f((bf16_t)(hv.x & 0xffff)) + w0 * bf2f((bf16_t)(y0.x & 0xffff)) + w1 * bf2f((bf16_t)(y1.x & 0xffff));
        v[j].y = ALPHA * bf2f((bf16_t)(hv.x >> 16)) + w0 * bf2f((bf16_t)(y0.x >> 16)) + w1 * bf2f((bf16_t)(y1.x >> 16));
        v[j].z = ALPHA * bf2f((bf16_t)(hv.y & 0xffff)) + w0 * bf2f((bf16_t)(y0.y & 0xffff)) + w1 * bf2f((bf16_t)(y1.y & 0xffff));
        v[j].w = ALPHA * bf2f((bf16_t)(hv.y >> 16)) + w0 * bf2f((bf16_t)(y0.y >> 16)) + w1 * bf2f((bf16_t)(y1.y >> 16));
        s += (v[j].x + v[j].y) + (v[j].z + v[j].w); }
    const float mean = wave_sum(s) * (1.f / D); float s2 = 0.f;
#pragma unroll
    for (int j = 0; j < 4; ++j) { v[j] = v[j] - mean; s2 += (v[j].x * v[j].x + v[j].y * v[j].y) + (v[j].z * v[j].z + v[j].w * v[j].w); }
    const float rstd = 1.0f / sqrtf(wave_sum(s2) * (1.f / D) + LN_EPS);
#pragma unroll
    for (int j = 0; j < 4; ++j) { const int c = j * 256 + lane * 4; const f32x4 g = *(const f32x4*)(g2 + c), bb = *(const f32x4*)(b2 + c);
        *(f32x4*)(out + (size_t)tok * D + c) = v[j] * rstd * g + bb; }
}

#define LAS __attribute__((address_space(3)))
#define GAS __attribute__((address_space(1)))
typedef short bf16x8 __attribute__((ext_vector_type(8)));
constexpr int NWAVES = 8, NTHR = 512;
constexpr int RING_OFF = 0, RING_BYTES = 131072;
constexpr int LDSCTL_OFF = RING_BYTES;
constexpr int MISC_OFF = LDSCTL_OFF;
constexpr int TB_OFF = LDSCTL_OFF + 128;
constexpr int GTAB_OFF = LDSCTL_OFF + 512;
constexpr int LDS_BYTES = 147456;
static_assert(GTAB_OFF + 4 * 256 * 4 <= LDS_BYTES, "LDS map");
constexpr int CW_TMO = 64;
constexpr int CW_BAR = 4096;
static_assert((CW_BAR + 3456) * 4 <= (int)CTL_BYTES, "ctl");

namespace pg8 {
constexpr int BM = 256, BK = 64, HALF = 128, HTB = HALF * BK * 2, STAGE_BYTES = 8 * HTB, NXCD = 8, WGM = 8;
__host__ __device__ __forceinline__ int lds_byte(int r, int c) { const int st = (r >> 4) * 2 + (c >> 5), rr = r & 15, cc = c & 31, ob = rr * 64 + cc * 2; return st * 1024 + (ob ^ (((ob >> 9) & 1) << 5)); }
__host__ __device__ __forceinline__ void stage_rc(int b, int& R, int& C) { const int st = b / 1024, sb = b % 1024, swz = sb ^ (((sb >> 9) & 1) << 5); R = (st >> 1) * 16 + swz / 64; C = (st & 1) * 32 + (swz % 64) / 2; }
__host__ __device__ __forceinline__ int perm32(int rho) { const int n = rho >> 4, i = rho & 15; return 8 * (i >> 2) + 4 * n + (i & 3); }
struct Unit { int pm, pn, e, ui; };

__device__ __forceinline__ unsigned cvt_pk_bf16(float lo, float hi) { unsigned r; asm volatile("v_cvt_pk_bf16_f32 %0, %1, %2" : "=v"(r) : "v"(lo), "v"(hi)); return r; }

__device__ __forceinline__ int xcd_remap(int L, int nwg) { const int q = nwg / NXCD, r = nwg % NXCD, xcd = L % NXCD, off = L / NXCD; return (xcd < r ? xcd * (q + 1) : r * (q + 1) + (xcd - r) * q) + off; }

struct DenseOrder {
    static constexpr bool GATHER = false;
    const bf16_t* A; const bf16_t* Bt; int K; int nM, nN, nwg, G, c;
    __device__ void init(const bf16_t* A_, const bf16_t* Bt_, int M, int N, int K_, int G_, int c_) { A = A_; Bt = Bt_; K = K_; nM = M / BM; nN = N / BM; nwg = nM * nN; G = G_; c = c_; }
    __device__ bool next(int i, Unit& u) const {
        const long L = (long)i * G + c; if (L >= nwg) return false;
        const int wgid = xcd_remap((int)L, nwg);
        const int nig = WGM * nN, gid = wgid / nig, fm = gid * WGM, gsz = (nM - fm) < WGM ? (nM - fm) : WGM;
        u.pm = fm + ((wgid % nig) % gsz); u.pn = (wgid % nig) / gsz; u.e = 0; u.ui = i; return true;
    }
    __device__ __forceinline__ const char* a_base(const Unit& u) const { return (const char*)A + (size_t)u.pm * (2 * HALF) * K * 2; }
    __device__ __forceinline__ const char* b_base(const Unit& u) const { return (const char*)Bt + (size_t)u.pn * (2 * HALF) * K * 2; }
    __device__ __forceinline__ unsigned goff(const Unit&, int) const { return 0u; }
};
struct MoeOrder {
    const bf16_t* A; const bf16_t* W; int K; int nN; size_t wstride  ; const LAS int* tb; const LAS unsigned* gtab; int nwg, G, c; bool gather;
    __device__ bool next(int i, Unit& u) const {
        const long L = (long)i * G + c; if (L >= nwg) return false;
        const int wgid = xcd_remap((int)L, nwg);
        u.pm = wgid / nN; u.pn = wgid % nN; u.ui = i;
        const int q = threadIdx.x & 31;
        const bool p = (q >= 1) && (tb[q] <= u.pm);
        u.e = __builtin_popcountll(__ballot(p) & 0xffffffffull); return true;
    }
    __device__ __forceinline__ const char* b_base(const Unit& u) const { return (const char*)W + ((size_t)u.e * wstride + (size_t)u.pn * (2 * HALF) * K) * 2; }
};
struct MoeGatherOrder : MoeOrder {
    static constexpr bool GATHER = true;
    __device__ __forceinline__ const char* a_base(const Unit&) const { return (const char*)A; }
    __device__ __forceinline__ unsigned goff(const Unit& u, int row) const { return gtab[(u.ui & 3) * 256 + row]; }
};
struct MoeDenseOrder : MoeOrder {
    static constexpr bool GATHER = false;
    __device__ __forceinline__ const char* a_base(const Unit& u) const { return (const char*)A + (size_t)u.pm * (2 * HALF) * K * 2; }
    __device__ __forceinline__ unsigned goff(const Unit&, int) const { return 0u; }
};

struct EpiProjF {
    static constexpr bool PERM = true;
    bf16_t* P;
    __device__ __forceinline__ void operator()(const f32x4 (&acc)[2][2][4][2], const Unit& u, int wr, int wc, int fr, int fq) const {
        const int row0 = u.pm * BM + wr * 64 + fr, col0 = u.pn * BM + wc * 32 + 8 * fq;
#pragma unroll
        for (int bj = 0; bj < 2; ++bj) {
            const int cb = u.pn * BM + bj * HALF;
            int kind = 0; float lg = 0.f;
            if (cb < C_KR) { kind = 1; lg = log2gamma(cb >> 7); } else if (cb < C_VR) { kind = 2; lg = log2gamma((cb - C_KR) >> 7); } else if (cb >= C_QA && cb < C_KA) kind = 3;
#pragma unroll
            for (int ai = 0; ai < 2; ++ai)
#pragma unroll
                for (int m = 0; m < 4; ++m) { const int row = row0 + ai * HALF + m * 16, i = row & (CH - 1);
                    float sc = 1.0f;
                    if (kind == 1) sc = exp2f(lg * (float)(i + 1)); else if (kind == 2) sc = KR_SCALE * exp2f(lg * (float)(CH - 1 - i)); else if (kind == 3) sc = QA_SCALE;
                    const f32x4 v0 = acc[ai][bj][m][0] * sc, v1 = acc[ai][bj][m][1] * sc;
                    u32x4 w; w.x = cvt_pk_bf16(v0[0], v0[1]); w.y = cvt_pk_bf16(v0[2], v0[3]); w.z = cvt_pk_bf16(v1[0], v1[1]); w.w = cvt_pk_bf16(v1[2], v1[3]);
                    *(u32x4*)(P + (size_t)row * INW + col0 + bj * HALF) = w; }
        }
    }
};
struct EpiZF {
    static constexpr bool PERM = false;
    const float* x; float* z;
    __device__ __forceinline__ void operator()(const f32x4 (&acc)[2][2][4][2], const Unit& u, int wr, int wc, int fr, int fq) const {
        const int row0 = u.pm * BM + wr * 64 + fr, col0 = u.pn * BM + wc * 32 + 4 * fq;
#pragma unroll
        for (int ai = 0; ai < 2; ++ai)
#pragma unroll
            for (int m = 0; m < 4; ++m) { const size_t off = (size_t)(row0 + ai * HALF + m * 16) * D + col0;
#pragma unroll
                for (int bj = 0; bj < 2; ++bj)
#pragma unroll
                    for (int n = 0; n < 2; ++n) { const f32x4 xv = *(const f32x4*)(x + off + bj * HALF + n * 16); *(f32x4*)(z + off + bj * HALF + n * 16) = xv * ALPHA + acc[ai][bj][m][n]; } }
    }
};
struct EpiActF {
    static constexpr bool PERM = true;
    bf16_t* act;
    __device__ __forceinline__ void operator()(const f32x4 (&acc)[2][2][4][2], const Unit& u, int wr, int wc, int fr, int fq) const {
        const int row0 = u.pm * BM + wr * 64 + fr, col0 = u.pn * HALF + wc * 32 + 8 * fq;
#pragma unroll
        for (int ai = 0; ai < 2; ++ai)
#pragma unroll
            for (int m = 0; m < 4; ++m) { const int row = row0 + ai * HALF + m * 16;
                float r[8];
#pragma unroll
                for (int n = 0; n < 2; ++n)
#pragma unroll
                    for (int j = 0; j < 4; ++j) { const float g = acc[ai][0][m][n][j], up = acc[ai][1][m][n][j]; r[n * 4 + j] = g * up * __builtin_amdgcn_rcpf(1.0f + __expf(-g)); }
                u32x4 w; w.x = cvt_pk_bf16(r[0], r[1]); w.y = cvt_pk_bf16(r[2], r[3]); w.z = cvt_pk_bf16(r[4], r[5]); w.w = cvt_pk_bf16(r[6], r[7]);
                *(u32x4*)(act + (size_t)row * DE + col0) = w; }
    }
};
struct EpiYsF {
    static constexpr bool PERM = true;
    bf16_t* ys;
    __device__ __forceinline__ void operator()(const f32x4 (&acc)[2][2][4][2], const Unit& u, int wr, int wc, int fr, int fq) const {
        const int row0 = u.pm * BM + wr * 64 + fr, col0 = u.pn * BM + wc * 32 + 8 * fq;
#pragma unroll
        for (int ai = 0; ai < 2; ++ai)
#pragma unroll
            for (int m = 0; m < 4; ++m) { const int row = row0 + ai * HALF + m * 16;
#pragma unroll
                for (int bj = 0; bj < 2; ++bj) { const f32x4 v0 = acc[ai][bj][m][0], v1 = acc[ai][bj][m][1];
                    u32x4 w; w.x = cvt_pk_bf16(v0[0], v0[1]); w.y = cvt_pk_bf16(v0[2], v0[3]); w.z = cvt_pk_bf16(v1[0], v1[1]); w.w = cvt_pk_bf16(v1[2], v1[3]);
                    *(u32x4*)(ys + (size_t)row * D + col0 + bj * HALF) = w; } }
    }
};

template <class Epi, class Sched, bool ALIGN_EPI>
__device__ __forceinline__ void gemm_phase(LAS unsigned char* lds, const Sched& S, const Epi& E) {
    constexpr bool GATHER = Sched::GATHER;
    const int tid = threadIdx.x, wid = __builtin_amdgcn_readfirstlane(tid >> 6), lane = tid & 63, wr = wid >> 2, wc = wid & 3, fr = lane & 15, fq = lane >> 4;
    const int K = S.K, nt = K / BK;
    unsigned voffA[2], voffB[2]; int RA[2];
    unsigned voffG[2][2];
#pragma unroll
    for (int i = 0; i < 2; ++i) { int R, C; stage_rc(tid * 16 + i * 8192, R, C); const int Rb = Epi::PERM ? ((R & ~31) + perm32(R & 31)) : R;
        RA[i] = R; voffA[i] = GATHER ? (unsigned)(C * 2) : (unsigned)(R * K + C) * 2u; voffB[i] = (unsigned)(Rb * K + C) * 2u; }
    const size_t kstep = (size_t)(BK * 2);
    const size_t hstep = (size_t)HALF * K * 2;
    const unsigned ldsw = (unsigned)wid * 1024u;
    const int aoff = lds_byte(wr * 64 + fr, fq * 8), boff = lds_byte(wc * 32 + fr, fq * 8);
#define PG8_SA(b, h) (((b) * 2 + (h)) * HTB)
#define PG8_SB(b, h) ((4 + (b) * 2 + (h)) * HTB)
#define PG8_STAGE_B(bufoff, gbase, h) do { _Pragma("unroll") for (int _i = 0; _i < 2; ++_i) \
        __builtin_amdgcn_global_load_lds((const unsigned*)((const char*)(gbase) + (h) * hstep + voffB[_i]), (LAS unsigned*)(lds + (bufoff) + ldsw + _i * 8192), 16, 0, 0); } while (0)
#define PG8_STAGE_A(bufoff, gbase, h) do { _Pragma("unroll") for (int _i = 0; _i < 2; ++_i) \
        __builtin_amdgcn_global_load_lds((const unsigned*)((const char*)(gbase) + (GATHER ? (size_t)voffG[h][_i] : (h) * hstep + voffA[_i])), (LAS unsigned*)(lds + (bufoff) + ldsw + _i * 8192), 16, 0, 0); } while (0)
#define PG8_LDA(dst, b, h) do { _Pragma("unroll") for (int m = 0; m < 4; ++m) _Pragma("unroll") for (int k = 0; k < 2; ++k) dst[m][k] = *(const LAS bf16x8*)(lds + PG8_SA(b, h) + aoff + m * 2048 + k * 1024); } while (0)
#define PG8_LDB(dst, b, h) do { _Pragma("unroll") for (int n = 0; n < 2; ++n) _Pragma("unroll") for (int k = 0; k < 2; ++k) dst[n][k] = *(const LAS bf16x8*)(lds + PG8_SB(b, h) + boff + n * 2048 + k * 1024); } while (0)
#define PG8_MMA(ai, bj, At, Bt) do { __builtin_amdgcn_s_setprio(1); _Pragma("unroll") for (int m = 0; m < 4; ++m) _Pragma("unroll") for (int n = 0; n < 2; ++n) _Pragma("unroll") for (int k = 0; k < 2; ++k) \
        acc[ai][bj][m][n] = __builtin_amdgcn_mfma_f32_16x16x32_bf16(Bt[n][k], At[m][k], acc[ai][bj][m][n], 0, 0, 0); __builtin_amdgcn_s_setprio(0); } while (0)
#define PG8_WAIT_V(n) asm volatile("s_waitcnt vmcnt(" #n ")" ::: "memory")
#define PG8_WAIT_L(n) asm volatile("s_waitcnt lgkmcnt(" #n ")" ::: "memory")
#define PG8_BAR __builtin_amdgcn_s_barrier()
#define PG8_SCHED __builtin_amdgcn_sched_barrier(0)
#define PG8_GOFF(u) do { if (GATHER) { _Pragma("unroll") for (int _h = 0; _h < 2; ++_h) _Pragma("unroll") for (int _i = 0; _i < 2; ++_i) voffG[_h][_i] = S.goff(u, _h * HALF + RA[_i]) + voffA[_i]; } } while (0)
    Unit cur, nxt; int ui = 0;
    if (!S.next(0, cur)) return;
    f32x4 acc[2][2][4][2];
#pragma unroll
    for (int a = 0; a < 2; ++a)
#pragma unroll
        for (int b = 0; b < 2; ++b)
#pragma unroll
            for (int m = 0; m < 4; ++m)
#pragma unroll
                for (int n = 0; n < 2; ++n) acc[a][b][m][n] = (f32x4){0.f, 0.f, 0.f, 0.f};
    bf16x8 At[4][2], B0[2][2], B1[2][2];
    const char* cA = S.a_base(cur); const char* cB = S.b_base(cur);
    voffG[0][0] = voffG[0][1] = voffG[1][0] = voffG[1][1] = 0u;
    PG8_GOFF(cur);
    PG8_STAGE_B(PG8_SB(0, 0), cB, 0); PG8_STAGE_B(PG8_SB(0, 1), cB, 1); PG8_STAGE_A(PG8_SA(0, 0), cA, 0); PG8_STAGE_A(PG8_SA(0, 1), cA, 1);
    if (wr == 1) PG8_BAR;
    PG8_WAIT_V(2); PG8_BAR;
    PG8_STAGE_B(PG8_SB(1, 0), cB + kstep, 0); PG8_STAGE_A(PG8_SA(1, 0), cA + kstep, 0); PG8_STAGE_B(PG8_SB(1, 1), cB + kstep, 1);
    PG8_WAIT_V(6); PG8_BAR;
    for (;;) {
        const bool has_next = S.next(ui + 1, nxt);
        const char* nA = has_next ? S.a_base(nxt) : cA; const char* nB = has_next ? S.b_base(nxt) : cB;
        for (int t = 0; t < nt; t += 2) {
            const bool last = (t == nt - 2);
            const char* a1 = cA + (size_t)(t + 1) * kstep;
            const char* a2 = last ? nA : cA + (size_t)(t + 2) * kstep; const char* b2 = last ? nB : cB + (size_t)(t + 2) * kstep;
            const char* a3 = a2 + kstep; const char* b3 = b2 + kstep;
            PG8_LDB(B0, 0, 0); PG8_LDB(B1, 0, 1); PG8_SCHED; PG8_LDA(At, 0, 0); PG8_STAGE_A(PG8_SA(1, 1), a1, 1);
            if (GATHER) { if (last && has_next) PG8_GOFF(nxt); }
            PG8_WAIT_V(8); PG8_WAIT_L(0); PG8_BAR; PG8_MMA(0, 0, At, B0); PG8_MMA(0, 1, At, B1); PG8_BAR; PG8_SCHED;
            PG8_LDA(At, 0, 1); PG8_STAGE_B(PG8_SB(0, 0), b2, 0); PG8_STAGE_B(PG8_SB(0, 1), b2, 1); PG8_STAGE_A(PG8_SA(0, 0), a2, 0);
            PG8_WAIT_V(8); PG8_WAIT_L(0); PG8_BAR; PG8_MMA(1, 0, At, B0); PG8_MMA(1, 1, At, B1); PG8_BAR; PG8_SCHED;
            PG8_LDB(B0, 1, 0); PG8_LDB(B1, 1, 1); PG8_SCHED; PG8_LDA(At, 1, 0); PG8_STAGE_A(PG8_SA(0, 1), a2, 1);
            PG8_WAIT_V(8); PG8_WAIT_L(0); PG8_BAR; PG8_MMA(0, 0, At, B0); PG8_MMA(0, 1, At, B1); PG8_BAR; PG8_SCHED;
            PG8_LDA(At, 1, 1); PG8_STAGE_B(PG8_SB(1, 0), b3, 0); PG8_STAGE_B(PG8_SB(1, 1), b3, 1); PG8_STAGE_A(PG8_SA(1, 0), a3, 0);
            PG8_WAIT_V(8); PG8_WAIT_L(0); PG8_BAR; PG8_MMA(1, 0, At, B0); PG8_MMA(1, 1, At, B1); PG8_BAR; PG8_SCHED;
        }
        if constexpr (ALIGN_EPI) { if (wr == 0) PG8_BAR; }
        E(acc, cur, wr, wc, fr, fq);
        if (!has_next) break;
#pragma unroll
        for (int a = 0; a < 2; ++a)
#pragma unroll
            for (int b = 0; b < 2; ++b)
#pragma unroll
                for (int m = 0; m < 4; ++m)
#pragma unroll
                    for (int n = 0; n < 2; ++n) acc[a][b][m][n] = (f32x4){0.f, 0.f, 0.f, 0.f};
        cur = nxt; cA = nA; cB = nB; ++ui;
        if constexpr (ALIGN_EPI) { if (wr == 1) PG8_BAR; }
    }
    PG8_WAIT_V(0);
    if constexpr (!ALIGN_EPI) { if (wr == 0) PG8_BAR; }
    PG8_BAR;
#undef PG8_SA
#undef PG8_SB
#undef PG8_STAGE_A
#undef PG8_STAGE_B
#undef PG8_LDA
#undef PG8_LDB
#undef PG8_MMA
#undef PG8_WAIT_V
#undef PG8_WAIT_L
#undef PG8_BAR
#undef PG8_SCHED
#undef PG8_GOFF
}
}

typedef GAS unsigned gu32;
#define RLX_AGENT __ATOMIC_RELAXED, __HIP_MEMORY_SCOPE_AGENT
#define XB_TMO      128
#define XB_XCNT(j)  (256  + 64 * (j))
#define XB_XSUB(j)  (1280 + 64 * (j))
#define XB_XGEN(j)  (2304 + 64 * (j))
#define XB_TOP      3328
#define XB_TOPGEN   3392
#define XCD_BAR_WORDS 3456
#define XB_SPIN_CAP (1u << 18)
__device__ __forceinline__ unsigned xb_ld(unsigned* p)              { return __hip_atomic_load(p, __ATOMIC_RELAXED, __HIP_MEMORY_SCOPE_AGENT); }
__device__ __forceinline__ unsigned xb_add(unsigned* p, unsigned v) { return __hip_atomic_fetch_add(p, v, __ATOMIC_RELAXED, __HIP_MEMORY_SCOPE_AGENT); }
__device__ __forceinline__ unsigned xb_xcc_id() { return (unsigned)__builtin_amdgcn_s_getreg((3 << 11) | 20) & 0xFu; }
#define XB_SPIN(cond, bar) do { unsigned _sp = 0; while (cond) { __builtin_amdgcn_s_sleep(1); \
    if ((++_sp & 255u) == 0u) { if (xb_ld(&(bar)[XB_TMO])) break; if (_sp > XB_SPIN_CAP) { atomicAdd(&(bar)[XB_TMO], 1u); break; } } } } while (0)
struct XcdBarrier { unsigned* bar; unsigned x; volatile LAS unsigned* st; };
__device__ __forceinline__ XcdBarrier xcd_barrier_post(unsigned* bar, volatile LAS unsigned* st) {
    XcdBarrier b; b.bar = bar; b.x = xb_xcc_id(); b.st = st;
    if (threadIdx.x == 0) (void)xb_add(&bar[XB_XCNT(b.x)], 1u);
    return b;
}
__device__ __forceinline__ void xcd_barrier_complete(unsigned* bar, unsigned x, unsigned& nloc, unsigned& nx) {
    const unsigned G = gridDim.x * gridDim.y * gridDim.z;
    unsigned sum, cnt, mine, sp = 0u;
    for (;;) {
        sum = 0u; cnt = 0u; mine = 0u;
#pragma unroll
        for (unsigned j = 0; j < 16; ++j) { const unsigned c = xb_ld(&bar[XB_XCNT(j)]); sum += c; cnt += (c > 0u) ? 1u : 0u; mine = (j == x) ? c : mine; }
        if (sum == G) break;
        __builtin_amdgcn_s_sleep(1);
        if ((++sp & 255u) == 0u) { if (xb_ld(&bar[XB_TMO])) break; if (sp > XB_SPIN_CAP) { atomicAdd(&bar[XB_TMO], 1u); break; } }
    }
    nloc = mine > 0u ? mine : 1u; nx = cnt > 0u ? cnt : 1u;
}
__device__ __forceinline__ void xcd_barrier(const XcdBarrier& b) {
    asm volatile("s_waitcnt vmcnt(0)" ::: "memory");
    __syncthreads();
    if (threadIdx.x == 0) {
        unsigned* bar = b.bar;
        __builtin_amdgcn_s_waitcnt(0);
        unsigned nloc = b.st[0], nx = b.st[1];
        if (nloc == 0u) { xcd_barrier_complete(bar, b.x, nloc, nx); b.st[0] = nloc; b.st[1] = nx; }
        const unsigned old = xb_add(&bar[XB_XSUB(b.x)], 1u);
        const unsigned gen = old / nloc;
        if (old + 1u == (gen + 1u) * nloc) {
            __builtin_amdgcn_fence(__ATOMIC_RELEASE, "agent");
            asm volatile("s_waitcnt vmcnt(0)" ::: "memory");
            const unsigned og = xb_add(&bar[XB_TOP], 1u);
            const unsigned tg = og / nx;
            if (og + 1u == (tg + 1u) * nx) xb_add(&bar[XB_TOPGEN], 1u);
            else XB_SPIN(xb_ld(&bar[XB_TOPGEN]) == tg, bar);
            __builtin_amdgcn_fence(__ATOMIC_ACQUIRE, "agent");
            xb_add(&bar[XB_XGEN(b.x)], 1u);
            asm volatile("s_waitcnt vmcnt(0)" ::: "memory");
        } else {
            XB_SPIN(xb_ld(&bar[XB_XGEN(b.x)]) == gen, bar);
            __builtin_amdgcn_fence(__ATOMIC_ACQUIRE, "agent");
            asm volatile("s_waitcnt vmcnt(0)" ::: "memory");
        }
    }
    __syncthreads();
}

struct Frame {
    LAS unsigned char* lds; volatile LAS unsigned* MISC; unsigned* ctl;
    int tid, lane, wave, vcu, G;
};
struct Args { const float* in[16]; float* out; unsigned char* ws; int ph_lo, ph_hi; };

__device__ __forceinline__ void p0_transpose_item(const float* W, int K, int N, bf16_t* Wt, int kind, LAS float* scr, int item, int lane) {
    const int nblk = N / 32, kb = item / nblk, nb = item % nblk, k0 = 64 * kb, n0 = 32 * nb;
#pragma unroll 8
    for (int i = 0; i < 32; ++i) { const int kk = 2 * i + (lane >> 5); scr[kk * 33 + (lane & 31)] = W[(size_t)(k0 + kk) * N + n0 + (lane & 31)]; }
    asm volatile("s_waitcnt lgkmcnt(0)" ::: "memory");
    const int c = lane & 7;
#pragma unroll
    for (int j = 0; j < 4; ++j) { const int nn = (lane >> 3) + 8 * j; const LAS float* s = scr + (8 * c) * 33 + nn; const int n = n0 + nn;
        const int row = (kind == 0) ? n : ((n >> 7) * 256 + (kind - 1) * 128 + (n & 127));
        u32x4 o; o.x = pk2(s[0 * 33], s[1 * 33]); o.y = pk2(s[2 * 33], s[3 * 33]); o.z = pk2(s[4 * 33], s[5 * 33]); o.w = pk2(s[6 * 33], s[7 * 33]);
        *(u32x4*)(Wt + (size_t)row * K + k0 + 8 * c) = o; }
    asm volatile("s_waitcnt lgkmcnt(0)" ::: "memory");
}
__device__ __forceinline__ void p0_prologue(Frame& F, const Args& a) {
    unsigned char* ws = a.ws;
    LAS float* scr = (LAS float*)(F.lds + RING_OFF + F.wave * 16384);
    const int gw = F.vcu * NWAVES + F.wave, NGW = F.G * NWAVES;
    const float* w_in = a.in[1]; const float* w_out = a.in[4]; const float* w_gate = a.in[11]; const float* w_up = a.in[12]; const float* w_down = a.in[13];
    bf16_t* Wi = (bf16_t*)(ws + WS_WI); bf16_t* Wo = (bf16_t*)(ws + WS_WO); bf16_t* Wgu = (bf16_t*)(ws + WS_WGU); bf16_t* Wd = (bf16_t*)(ws + WS_WD);
    constexpr int I_IN = (D / 64) * (INW / 32), I_OUT = (D / 64) * (D / 32), I_G = (D / 64) * (DE / 32), I_D = (DE / 64) * (D / 32);
    constexpr int NITEMS = I_IN + I_OUT + NE * (2 * I_G + I_D);
    for (int it = gw; it < NITEMS; it += NGW) {
        int r = it;
        if (r < I_IN) { p0_transpose_item(w_in, D, INW, Wi, 0, scr, r, F.lane); continue; } r -= I_IN;
        if (r < I_OUT) { p0_transpose_item(w_out, D, D, Wo, 0, scr, r, F.lane); continue; } r -= I_OUT;
        const int e = r / (2 * I_G + I_D); r -= e * (2 * I_G + I_D);
        if (r < I_G) { p0_transpose_item(w_gate + (size_t)e * D * DE, D, DE, Wgu + (size_t)e * 1024 * D, 1, scr, r, F.lane); continue; } r -= I_G;
        if (r < I_G) { p0_transpose_item(w_up + (size_t)e * D * DE, D, DE, Wgu + (size_t)e * 1024 * D, 2, scr, r, F.lane); continue; } r -= I_G;
        p0_transpose_item(w_down + (size_t)e * DE * D, DE, D, Wd + (size_t)e * D * DE, 0, scr, r, F.lane);
    }
    { const float* x = a.in[0]; bf16_t* xb = (bf16_t*)(ws + WS_XB); const size_t n4 = (size_t)T * D / 4;
      for (size_t i = (size_t)F.vcu * NTHR + F.tid; i < n4; i += (size_t)F.G * NTHR) { const f32x4 v = ((const f32x4*)x)[i]; u32x2 o; o.x = pk2(v.x, v.y); o.y = pk2(v.z, v.w); ((u32x2*)xb)[i] = o; } }
    { float* rw = (float*)(ws + WS_RW); const float* wgr = a.in[7]; const float* bgr = a.in[8]; const float* wer = a.in[9]; const float* ber = a.in[10];
      for (int i = F.vcu * NTHR + F.tid; i < 36 * D; i += F.G * NTHR) { const int c = i / D, k = i % D;
          rw[i] = (c < 4) ? wgr[k * NG + c] : wer[((size_t)((c - 4) >> 3) * D + k) * EPG + ((c - 4) & 7)]; }
      if (F.vcu == 0 && F.tid < 36) rw[36 * D + F.tid] = F.tid < 4 ? bgr[F.tid] : ber[F.tid - 4]; }
}

__device__ __forceinline__ void p4_route(Frame& F, const Args& a) {
    unsigned char* ws = a.ws;
    const float* z = a.out; const float* g1 = a.in[5]; const float* b1 = a.in[6]; const float* rw = (const float*)(ws + WS_RW);
    bf16_t* hb = (bf16_t*)(ws + WS_XB); unsigned* cnt = F.ctl + CW_CNT; int* list = (int*)(ws + WS_LIST);
    int* tok_e = (int*)(ws + WS_TOK); int* tok_pos = tok_e + 2 * T; float* tok_w = (float*)(tok_pos + 2 * T);
    const int lane = F.lane;
    for (int tok = F.vcu * NWAVES + F.wave; tok < T; tok += F.G * NWAVES) {
        f32x4 v[4]; float s = 0.f;
#pragma unroll
        for (int j = 0; j < 4; ++j) { v[j] = *(const f32x4*)(z + (size_t)tok * D + j * 256 + lane * 4); s += (v[j].x + v[j].y) + (v[j].z + v[j].w); }
        const float mean = wave_sum(s) * (1.f / D); float s2 = 0.f;
#pragma unroll
        for (int j = 0; j < 4; ++j) { v[j] = v[j] - mean; s2 += (v[j].x * v[j].x + v[j].y * v[j].y) + (v[j].z * v[j].z + v[j].w * v[j].w); }
        const float rstd = 1.0f / sqrtf(wave_sum(s2) * (1.f / D) + LN_EPS);
#pragma unroll
        for (int j = 0; j < 4; ++j) { const f32x4 g = *(const f32x4*)(g1 + j * 256 + lane * 4), bb = *(const f32x4*)(b1 + j * 256 + lane * 4);
            v[j] = v[j] * rstd * g + bb;
            u32x2 w; w.x = pk2(v[j].x, v[j].y); w.y = pk2(v[j].z, v[j].w); *(u32x2*)(hb + (size_t)tok * D + j * 256 + lane * 4) = w; }
        float lgv[4];
#pragma unroll
        for (int c = 0; c < 4; ++c) { float t = 0.f;
#pragma unroll
            for (int j = 0; j < 4; ++j) { const f32x4 w = *(const f32x4*)(rw + (size_t)c * D + j * 256 + lane * 4); t += v[j].x * w.x + v[j].y * w.y + v[j].z * w.z + v[j].w * w.w; }
            lgv[c] = wave_sum(t) + rw[36 * D + c]; }
        int gi = 0; float gm = lgv[0];
        if (lgv[1] > gm) { gm = lgv[1]; gi = 1; }
        if (lgv[2] > gm) { gm = lgv[2]; gi = 2; }
        if (lgv[3] > gm) { gm = lgv[3]; gi = 3; }
        const float gs = __expf(lgv[0] - gm) + __expf(lgv[1] - gm) + __expf(lgv[2] - gm) + __expf(lgv[3] - gm);
        const float gwt = 1.0f / gs;
        float el[8];
#pragma unroll
        for (int e = 0; e < 8; ++e) { const int c = 4 + gi * 8 + e; float t = 0.f;
#pragma unroll
            for (int j = 0; j < 4; ++j) { const f32x4 w = *(const f32x4*)(rw + (size_t)c * D + j * 256 + lane * 4); t += v[j].x * w.x + v[j].y * w.y + v[j].z * w.z + v[j].w * w.w; }
            el[e] = wave_sum(t) + rw[36 * D + c]; }
        int i0 = 0; float l0 = el[0];
#pragma unroll
        for (int e = 1; e < 8; ++e) if (el[e] > l0) { l0 = el[e]; i0 = e; }
        int i1 = -1; float l1 = -INFINITY;
#pragma unroll
        for (int e = 0; e < 8; ++e) if (e != i0 && el[e] > l1) { l1 = el[e]; i1 = e; }
        const float e1 = __expf(l1 - l0); const float w0 = gwt / (1.f + e1), w1 = gwt * e1 / (1.f + e1);
        if (lane == 0) {
            const int e0 = gi * 8 + i0, e1i = gi * 8 + i1;
            const int p0 = (int)atomicAdd(&cnt[e0], 1u), p1 = (int)atomicAdd(&cnt[e1i], 1u);
            list[(size_t)e0 * LIST_CAP + p0] = tok; list[(size_t)e1i * LIST_CAP + p1] = tok;
            tok_e[tok * 2] = e0; tok_e[tok * 2 + 1] = e1i; tok_pos[tok * 2] = p0; tok_pos[tok * 2 + 1] = p1; tok_w[tok * 2] = w0; tok_w[tok * 2 + 1] = w1;
        }
    }
}
__device__ __forceinline__ void moe_setup(Frame& F) {
    LAS int* tb = (LAS int*)(F.lds + TB_OFF);
    if (F.wave == 0) { const int lane = F.lane;
        int c = lane < NE ? (((int)__hip_atomic_load(F.ctl + CW_CNT + (lane & 31), RLX_AGENT) + 255) >> 8) : 0;
        int s = c;
#pragma unroll
        for (int o = 1; o < 32; o <<= 1) { const int t = __shfl_up(s, o); if (lane >= o) s += t; }
        if (lane < NE) tb[lane + 1] = s;
        if (lane == 0) tb[0] = 0; }
    asm volatile("s_waitcnt vmcnt(0) lgkmcnt(0)" ::: "memory"); __syncthreads();
}
__device__ __forceinline__ void p7_final(Frame& F, const Args& a) {
    unsigned char* ws = a.ws;
    const bf16_t* hb = (const bf16_t*)(ws + WS_XB); const bf16_t* ys = (const bf16_t*)(ws + WS_YS);
    const int* tok_e = (const int*)(ws + WS_TOK); const int* tok_pos = tok_e + 2 * T; const float* tok_w = (const float*)(tok_pos + 2 * T);
    const float* g2 = a.in[14]; const float* b2 = a.in[15]; float* out = a.out;
    const LAS int* tb = (const LAS int*)(F.lds + TB_OFF);
    const int lane = F.lane;
    for (int tok = F.vcu * NWAVES + F.wave; tok < T; tok += F.G * NWAVES) {
        const int s0 = tb[tok_e[tok * 2]] * 256 + tok_pos[tok * 2], s1 = tb[tok_e[tok * 2 + 1]] * 256 + tok_pos[tok * 2 + 1];
        const float w0 = tok_w[tok * 2], w1 = tok_w[tok * 2 + 1];
        f32x4 v[4]; float s = 0.f;
#pragma unroll
        for (int j = 0; j < 4; ++j) { const int c = j * 256 + lane * 4;
            const u32x2 hv = *(const u32x2*)(hb + (size_t)tok * D + c), y0 = *(const u32x2*)(ys + (size_t)s0 * D + c), y1 = *(const u32x2*)(ys + (size_t)s1 * D + c);
            v[j].x = ALPHA * bf2f((bf16_t)(hv.x & 0xffff)) + w0 * bf2f((bf16_t)(y0.x & 0xffff)) + w1 * bf2f((bf16_t)(y1.x & 0xffff));
            v[j].y = ALPHA * bf2f((bf16_t)(hv.x >> 16)) + w0 * bf2f((bf16_t)(y0.x >> 16)) + w1 * bf2f((bf16_t)(y1.x >> 16));
            v[j].z = ALPHA * bf2f((bf16_t)(hv.y & 0xffff)) + w0 * bf2f((bf16_t)(y0.y & 0xffff)) + w1 * bf2f((bf16_t)(y1.y & 0xffff));
            v[j].w = ALPHA * bf2f((bf16_t)(hv.y >> 16)) + w0 * bf2f((bf16_t)(y0.y >> 16)) + w1 * bf2f((bf16_t)(y1.y >> 16));
            s += (v[j].x + v[j].y) + (v[j].z + v[j].w); }
        const float mean = wave_sum(s) * (1.f / D); float s2 = 0.f;
#pragma unroll
        for (int j = 0; j < 4; ++j) { v[j] = v[j] - mean; s2 += (v[j].x * v[j].x + v[j].y * v[j].y) + (v[j].z * v[j].z + v[j].w * v[j].w); }
        const float rstd = 1.0f / sqrtf(wave_sum(s2) * (1.f / D) + LN_EPS);
#pragma unroll
        for (int j = 0; j < 4; ++j) { const int c = j * 256 + lane * 4; const f32x4 g = *(const f32x4*)(g2 + c), bb = *(const f32x4*)(b2 + c);
            *(f32x4*)(out + (size_t)tok * D + c) = v[j] * rstd * g + bb; }
    }
}
namespace att {
typedef float f32x16 __attribute__((ext_vector_type(16)));
typedef short s16x4 __attribute__((ext_vector_type(4)));
constexpr int TILE_B = 32768;
__device__ __forceinline__ int pc_row(int pc, int lane) { return 8 * (pc >> 1) + ((lane >> 2) & 7); }
__device__ __forceinline__ int pc_ch(int pc, int lane, int row) { return 8 * (pc & 1) + 4 * (lane >> 5) + ((lane & 3) ^ ((row >> 2) & 3)); }
__device__ __forceinline__ unsigned rr_base(int lane, int odd) { const int q31 = lane & 31, hi = lane >> 5; return 2048u * (q31 >> 3) + 64u * (q31 & 7) + 16u * ((unsigned)(2 * odd + hi) ^ ((q31 >> 2) & 3)); }
__device__ __forceinline__ unsigned tr_base(int lane, int t) { const int hi = lane >> 5, q = (lane & 15) >> 2, p = lane & 3, blk = (lane >> 4) & 1;
    return 2048u * t + 64u * (4 * hi + q) + 16u * ((unsigned)(2 * blk + (p >> 1)) ^ (unsigned)(2 * t + hi)) + 8u * (p & 1); }
__device__ __forceinline__ int crow(int r, int hi) { return (r & 3) + 8 * (r >> 2) + 4 * hi; }
__device__ __forceinline__ unsigned cvtpk(float lo, float hi) { typedef float f32x2_t __attribute__((ext_vector_type(2))); typedef __bf16 bf16x2_t __attribute__((ext_vector_type(2)));
    f32x2_t v = {lo, hi}; bf16x2_t b = __builtin_convertvector(v, bf16x2_t); return __builtin_bit_cast(unsigned, b); }
__device__ __forceinline__ s16x4 vtr(const LAS unsigned char* p) { return __builtin_bit_cast(s16x4, __builtin_amdgcn_ds_read_tr16_b64_v4i16((LAS s16x4*)p)); }
__device__ __forceinline__ float xhalf_sum(float v) { return v + __shfl_xor(v, 32); }
__device__ __forceinline__ float xhalf_max(float v) { return fmaxf(v, __shfl_xor(v, 32)); }
#define ATT_GLDS(src, dst) __builtin_amdgcn_global_load_lds((const unsigned*)(src), (LAS unsigned*)(dst), 16, 0, 0)

__device__ __forceinline__ void ret_load(LAS unsigned char* tile, const bf16_t* proj, int b, int h, int m, int wid, int lane) {
    const bf16_t* Kg = proj + (size_t)(b * SEQ + m * CH) * INW + C_KR + h * RET_D;
    const bf16_t* Vg = proj + (size_t)(b * SEQ + m * CH) * INW + C_VR + h * RET_D;
#pragma unroll
    for (int k = 0; k < 4; ++k) { const int pc = wid * 4 + k, row = pc_row(pc, lane), ch = pc_ch(pc, lane, row);
        ATT_GLDS(Kg + (size_t)row * INW + ch * 8, tile + pc * 1024);
        ATT_GLDS(Vg + (size_t)row * INW + ch * 8, tile + TILE_B + pc * 1024); }
}
__device__ __forceinline__ void swa_load(LAS unsigned char* tile, const bf16_t* proj, int b, int kvh, int n, int wid, int lane) {
#pragma unroll
    for (int k = 0; k < 4; ++k) { const int pc = wid * 4 + k, row = pc_row(pc, lane), ch = pc_ch(pc, lane, row);
        int t = (n - 1) * WIN + row + 128 * (ch >> 3); t = t < 0 ? 0 : t;
        const bf16_t* src = proj + (size_t)(b * SEQ + t) * INW + kvh * SWA_D + (ch & 7) * 8;
        ATT_GLDS(src + C_KA, tile + pc * 1024);
        ATT_GLDS(src + C_VA, tile + TILE_B + pc * 1024); }
}

__device__ __forceinline__ void ret_chunk(LAS unsigned char* ring, const bf16_t* proj, const float* gn_g, bf16_t* o, int b, int h, int n, int wid, int lane) {
    const int rb = wid & 3, kh = wid >> 2, q31 = lane & 31, hi = lane >> 5;
    const float lg = log2gamma(h);
    bf16x8 qf[8];
    { const bf16_t* Qg = proj + (size_t)(b * SEQ + n * CH + 32 * rb + q31) * INW + C_QR + h * RET_D + 8 * hi;
#pragma unroll
      for (int s = 0; s < 8; ++s) qf[s] = *(const bf16x8*)(Qg + 16 * s); }
    f32x16 O[4];
#pragma unroll
    for (int d = 0; d < 4; ++d) O[d] = f32x16{};
    const unsigned kb0 = rr_base(lane, 0) + 16384u * kh, kb1 = rr_base(lane, 1) + 16384u * kh, vb0 = tr_base(lane, 0) + 16384u * kh + TILE_B, vb1 = tr_base(lane, 1) + 16384u * kh + TILE_B;
    ret_load(ring, proj, b, h, 0, wid, lane);
    for (int m = 0; m <= n; ++m) {
        LAS unsigned char* Kt = ring + (m & 1) * 2 * TILE_B;
        const LAS unsigned char* K0 = Kt + kb0; const LAS unsigned char* K1 = Kt + kb1; const LAS unsigned char* V0 = Kt + vb0; const LAS unsigned char* V1 = Kt + vb1;
        asm volatile("s_waitcnt vmcnt(0)" ::: "memory"); __syncthreads();
        if (m < n) ret_load(ring + ((m + 1) & 1) * 2 * TILE_B, proj, b, h, m + 1, wid, lane);
        const bool diag = (m == n);
        const float c = exp2f(lg * (float)((n - m - 1) * CH));
#pragma unroll
        for (int kb = 0; kb < 2; ++kb) {
            const int key0 = 64 * kh + 32 * kb;
            if (diag && key0 > 32 * rb + 31) continue;
            f32x16 X = f32x16{};
#pragma unroll
            for (int s = 0; s < 8; ++s) { const bf16x8 kf = *(const LAS bf16x8*)(((s & 1) ? K1 : K0) + 8192 * kb + 512 * (s >> 1)); X = __builtin_amdgcn_mfma_f32_32x32x16_bf16(kf, qf[s], X, 0, 0, 0); }
#pragma unroll
            for (int r = 0; r < 16; ++r) { float v = X[r] * c; if (diag && (key0 + crow(r, hi) > 32 * rb + q31)) v = 0.f; X[r] = v; }
#pragma unroll
            for (int sp = 0; sp < 2; ++sp) {
                u32x4 pw; pw.x = cvtpk(X[8 * sp + 0], X[8 * sp + 1]); pw.y = cvtpk(X[8 * sp + 2], X[8 * sp + 3]); pw.z = cvtpk(X[8 * sp + 4], X[8 * sp + 5]); pw.w = cvtpk(X[8 * sp + 6], X[8 * sp + 7]);
                const bf16x8 pf = __builtin_bit_cast(bf16x8, pw);
#pragma unroll
                for (int d = 0; d < 4; ++d) {
                    const s16x4 lo = vtr(V0 + 8192 * kb + 4096 * sp + 512 * d);
                    const s16x4 hh = vtr(V1 + 8192 * kb + 4096 * sp + 512 * d);
                    const bf16x8 vf = (bf16x8){lo[0], lo[1], lo[2], lo[3], hh[0], hh[1], hh[2], hh[3]};
                    O[d] = __builtin_amdgcn_mfma_f32_32x32x16_bf16(vf, pf, O[d], 0, 0, 0);
                }
            }
        }
    }
    __syncthreads();
    LAS float* cs = (LAS float*)ring;
    if (kh == 1) {
#pragma unroll
        for (int d = 0; d < 4; ++d)
#pragma unroll
            for (int r = 0; r < 16; ++r) cs[((rb * 4 + d) * 16 + r) * 64 + lane] = O[d][r];
    }
    __syncthreads();
    if (kh == 0) {
#pragma unroll
        for (int d = 0; d < 4; ++d)
#pragma unroll
            for (int r = 0; r < 16; ++r) O[d][r] += cs[((rb * 4 + d) * 16 + r) * 64 + lane];
        float s = 0.f;
#pragma unroll
        for (int d = 0; d < 4; ++d)
#pragma unroll
            for (int r = 0; r < 16; ++r) s += O[d][r];
        const float mu = xhalf_sum(s) * (1.f / RET_D);
        float s2 = 0.f;
#pragma unroll
        for (int d = 0; d < 4; ++d)
#pragma unroll
            for (int r = 0; r < 16; ++r) { const float t = O[d][r] - mu; O[d][r] = t; s2 += t * t; }
        const float rs = 1.0f / sqrtf(xhalf_sum(s2) * (1.f / RET_D) + GN_EPS);
        const size_t tok = (size_t)(b * SEQ + n * CH + 32 * rb + q31);
        const bf16_t* gp = proj + tok * INW + C_GR + h * RET_D; bf16_t* op = o + tok * D + h * RET_D; const float* gg = gn_g + h * RET_D;
#pragma unroll
        for (int d = 0; d < 4; ++d)
#pragma unroll
            for (int r4 = 0; r4 < 4; ++r4) { const int dd = 32 * d + 8 * r4 + 4 * hi;
                const u32x2 gv = *(const u32x2*)(gp + dd); const f32x4 gw = *(const f32x4*)(gg + dd);
                const float g0 = bf2f((bf16_t)(gv.x & 0xffff)), g1 = bf2f((bf16_t)(gv.x >> 16)), g2 = bf2f((bf16_t)(gv.y & 0xffff)), g3 = bf2f((bf16_t)(gv.y >> 16));
                u32x2 w; w.x = cvtpk(O[d][4 * r4 + 0] * rs * gw.x * siluf(g0), O[d][4 * r4 + 1] * rs * gw.y * siluf(g1));
                w.y = cvtpk(O[d][4 * r4 + 2] * rs * gw.z * siluf(g2), O[d][4 * r4 + 3] * rs * gw.w * siluf(g3));
                *(u32x2*)(op + dd) = w; }
    }
    __syncthreads();
}

__device__ __forceinline__ void swa_unit(LAS unsigned char* ring, const bf16_t* proj, const float* sinks, bf16_t* o, int b, int kvh, int n, int wid, int lane) {
    const int q31 = lane & 31, hi = lane >> 5;
    const LAS unsigned char* K0 = ring + rr_base(lane, 0); const LAS unsigned char* K1 = ring + rr_base(lane, 1);
    const LAS unsigned char* V0 = ring + TILE_B + tr_base(lane, 0); const LAS unsigned char* V1 = ring + TILE_B + tr_base(lane, 1);
    swa_load(ring, proj, b, kvh, n, wid, lane);
    asm volatile("s_waitcnt vmcnt(0)" ::: "memory"); __syncthreads();
    const int g = wid >> 1, hq = kvh * SWA_G + g;
    const float slope2 = exp2f(-(float)(hq + 1)) * LOG2E, sink2 = sinks[hq] * LOG2E;
#pragma unroll 1
    for (int tk = 0; tk < 2; ++tk) {
        const int rb = 2 * (wid & 1) + tk;
        const int qi = 32 * rb + q31;
        const size_t tok = (size_t)(b * SEQ + n * WIN + qi);
        bf16x8 qf[4];
        { const bf16_t* Qg = proj + tok * INW + C_QA + hq * SWA_D + 8 * hi;
#pragma unroll
          for (int s = 0; s < 4; ++s) qf[s] = *(const bf16x8*)(Qg + 16 * s); }
        f32x16 X[5];
#pragma unroll
        for (int kk = 0; kk < 5; ++kk) { const int key0 = 32 * (rb + kk);
            const int boff = 8192 * ((key0 >> 5) & 3) + 1024 * (key0 >> 7);
            f32x16 x = f32x16{};
#pragma unroll
            for (int s = 0; s < 4; ++s) { const bf16x8 kf = *(const LAS bf16x8*)(((s & 1) ? K1 : K0) + boff + 512 * (s >> 1)); x = __builtin_amdgcn_mfma_f32_32x32x16_bf16(kf, qf[s], x, 0, 0, 0); }
            X[kk] = x; }
        float mx = sink2;
#pragma unroll
        for (int kk = 0; kk < 5; ++kk)
#pragma unroll
            for (int r = 0; r < 16; ++r) { const int j = 32 * (rb + kk) + crow(r, hi); const int dist = qi + WIN - j;
                const bool valid = (dist >= 0) && (dist < WIN) && (n > 0 || j >= WIN);
                const float v = valid ? X[kk][r] - slope2 * (float)dist : -INFINITY; X[kk][r] = v; mx = fmaxf(mx, v); }
        mx = xhalf_max(mx);
        float l = 0.f;
#pragma unroll
        for (int kk = 0; kk < 5; ++kk)
#pragma unroll
            for (int r = 0; r < 16; ++r) { const float p = exp2f(X[kk][r] - mx); X[kk][r] = p; l += p; }
        l = xhalf_sum(l) + exp2f(sink2 - mx);
        f32x16 O[2]; O[0] = f32x16{}; O[1] = f32x16{};
#pragma unroll
        for (int kk = 0; kk < 5; ++kk) { const int key0 = 32 * (rb + kk); const int boff = 8192 * ((key0 >> 5) & 3) + 1024 * (key0 >> 7);
#pragma unroll
            for (int sp = 0; sp < 2; ++sp) {
                u32x4 pw; pw.x = cvtpk(X[kk][8 * sp + 0], X[kk][8 * sp + 1]); pw.y = cvtpk(X[kk][8 * sp + 2], X[kk][8 * sp + 3]); pw.z = cvtpk(X[kk][8 * sp + 4], X[kk][8 * sp + 5]); pw.w = cvtpk(X[kk][8 * sp + 6], X[kk][8 * sp + 7]);
                const bf16x8 pf = __builtin_bit_cast(bf16x8, pw);
#pragma unroll
                for (int d = 0; d < 2; ++d) {
                    const s16x4 lo = vtr(V0 + boff + 4096 * sp + 512 * d);
                    const s16x4 hh = vtr(V1 + boff + 4096 * sp + 512 * d);
                    const bf16x8 vf = (bf16x8){lo[0], lo[1], lo[2], lo[3], hh[0], hh[1], hh[2], hh[3]};
                    O[d] = __builtin_amdgcn_mfma_f32_32x32x16_bf16(vf, pf, O[d], 0, 0, 0);
                }
            } }
        const float rl = 1.0f / l;
        bf16_t* op = o + tok * D + RET_W + hq * SWA_D;
#pragma unroll
        for (int d = 0; d < 2; ++d)
#pragma unroll
            for (int r4 = 0; r4 < 4; ++r4) { const int dd = 32 * d + 8 * r4 + 4 * hi;
                u32x2 w; w.x = cvtpk(O[d][4 * r4 + 0] * rl, O[d][4 * r4 + 1] * rl); w.y = cvtpk(O[d][4 * r4 + 2] * rl, O[d][4 * r4 + 3] * rl);
                *(u32x2*)(op + dd) = w; }
    }
    __syncthreads();
}
#undef ATT_GLDS
}

__device__ __forceinline__ void p2_attention(Frame& F, const Args& a) {
    unsigned char* ws = a.ws;
    const bf16_t* proj = (const bf16_t*)(ws + WS_PROJ); bf16_t* o = (bf16_t*)(ws + WS_XB);
    LAS unsigned char* ring = F.lds + RING_OFF;
    for (int it = F.vcu; it < BATCH * RET_H * (NCH / 2); it += F.G) {
        const int b = it / (RET_H * (NCH / 2)), h = (it / (NCH / 2)) % RET_H, j = it % (NCH / 2);
        att::ret_chunk(ring, proj, a.in[2], o, b, h, NCH - 1 - j, F.wave, F.lane);
        att::ret_chunk(ring, proj, a.in[2], o, b, h, j, F.wave, F.lane);
    }
    for (int it = F.vcu; it < BATCH * SWA_KV * (SEQ / WIN); it += F.G) {
        const int b = it / (SWA_KV * (SEQ / WIN)), kvh = (it / (SEQ / WIN)) % SWA_KV, n = it % (SEQ / WIN);
        att::swa_unit(ring, proj, a.in[3], o, b, kvh, n, F.wave, F.lane);
    }
}
constexpr int NPH = 8;
#ifndef OPT_P2
#define OPT_P2 1
#endif
__global__ void __launch_bounds__(NTHR, 2) mk_fwd(Args args, int li, int pad) {
    extern __shared__ __attribute__((aligned(16))) unsigned char lds_raw[];
    Frame F;
    F.lds = (LAS unsigned char*)lds_raw;
    F.MISC = (volatile LAS unsigned*)(F.lds + MISC_OFF);
    F.tid = threadIdx.x; F.lane = F.tid & 63; F.wave = __builtin_amdgcn_readfirstlane(F.tid >> 6);
    F.G = gridDim.x; { const int bx = blockIdx.x; F.vcu = (F.G % 8 == 0) ? (bx % 8) * (F.G / 8) + bx / 8 : bx; }
    unsigned char* ws = args.ws;
    F.ctl = (unsigned*)(ws + WS_CTL);
    for (int u = F.tid; u < (LDS_BYTES - LDSCTL_OFF) / 4; u += NTHR) ((LAS unsigned*)(F.lds + LDSCTL_OFF))[u] = 0u;
    __syncthreads();
    const int lo = args.ph_lo, hi = args.ph_hi;
    XcdBarrier bar; bar.bar = F.ctl + CW_BAR + li * XCD_BAR_WORDS; bar.x = 0; bar.st = nullptr;
    if (hi - lo > 1) bar = xcd_barrier_post(F.ctl + CW_BAR + li * XCD_BAR_WORDS, F.MISC + 8);
#define IN(k) (lo <= (k) && (k) < hi)
#define BOTH(k) (IN(k) && IN((k) + 1))
#define GRID_BAR() xcd_barrier(bar)
    bf16_t* Wi = (bf16_t*)(ws + WS_WI); bf16_t* Wo = (bf16_t*)(ws + WS_WO); bf16_t* Wgu = (bf16_t*)(ws + WS_WGU); bf16_t* Wd = (bf16_t*)(ws + WS_WD);
    bf16_t* xb = (bf16_t*)(ws + WS_XB); bf16_t* proj = (bf16_t*)(ws + WS_PROJ); bf16_t* act = (bf16_t*)(ws + WS_PROJ); bf16_t* ys = (bf16_t*)(ws + WS_YS);

    if (IN(0)) { p0_prologue(F, args); if (BOTH(0)) GRID_BAR(); }
    if (IN(1)) {
        pg8::DenseOrder S; S.init(xb, Wi, T, INW, D, F.G, (int)blockIdx.x);
        pg8::EpiProjF E{proj};
        pg8::gemm_phase<pg8::EpiProjF, pg8::DenseOrder, true>(F.lds + RING_OFF, S, E);
        if (BOTH(1)) GRID_BAR();
    }
    if (IN(2)) {
#if OPT_P2
        p2_attention(F, args);
#endif
        if (BOTH(2)) GRID_BAR();
    }
    if (IN(3)) {
        pg8::DenseOrder S; S.init(xb  , Wo, T, D, D, F.G, (int)blockIdx.x);
        pg8::EpiZF E{args.in[0], args.out};
        pg8::gemm_phase<pg8::EpiZF, pg8::DenseOrder, false>(F.lds + RING_OFF, S, E);
        if (BOTH(3)) GRID_BAR();
    }
    if (IN(4)) { p4_route(F, args); if (BOTH(4)) GRID_BAR(); }
    if (IN(5)) {
        moe_setup(F);
        const LAS int* tb = (const LAS int*)(F.lds + TB_OFF);
        LAS unsigned* gtab = (LAS unsigned*)(F.lds + GTAB_OFF);
        pg8::MoeGatherOrder S; S.A = xb  ; S.W = Wgu; S.K = D; S.nN = 4; S.wstride = (size_t)1024 * D; S.tb = tb; S.gtab = gtab; S.nwg = tb[NE] * 4; S.G = F.G; S.c = (int)blockIdx.x; S.gather = true;
        {
            const int* list = (const int*)(ws + WS_LIST);
            for (int idx = F.tid; idx < 4 * 256; idx += NTHR) { const int i = idx >> 8, r = idx & 255; pg8::Unit u;
                if (S.next(i, u)) { const int local = (u.pm - tb[u.e]) * 256 + r; const int c = (int)__hip_atomic_load(F.ctl + CW_CNT + u.e, RLX_AGENT);
                    const int tok = list[(size_t)u.e * LIST_CAP + (local < c ? local : 0)]; gtab[i * 256 + r] = (unsigned)tok * (unsigned)(D * 2); } }
            asm volatile("s_waitcnt vmcnt(0) lgkmcnt(0)" ::: "memory"); __syncthreads();
        }
        pg8::EpiActF E{act};
        pg8::gemm_phase<pg8::EpiActF, pg8::MoeGatherOrder, true>(F.lds + RING_OFF, S, E);
        if (BOTH(5)) GRID_BAR();
    }
    if (IN(6)) {
        moe_setup(F);
        const LAS int* tb = (const LAS int*)(F.lds + TB_OFF);
        pg8::MoeDenseOrder S; S.A = act; S.W = Wd; S.K = DE; S.nN = 4; S.wstride = (size_t)D * DE; S.tb = tb; S.gtab = nullptr; S.nwg = tb[NE] * 4; S.G = F.G; S.c = (int)blockIdx.x; S.gather = false;
        pg8::EpiYsF E{ys};
        pg8::gemm_phase<pg8::EpiYsF, pg8::MoeDenseOrder, true>(F.lds + RING_OFF, S, E);
        if (BOTH(6)) GRID_BAR();
    }
    if (IN(7)) { moe_setup(F); p7_final(F, args); }
#undef IN
#undef BOTH
#undef GRID_BAR
}

static void launch_mk(const Args& a0, int lo, int hi, int li, int grid, hipStream_t stream) {
    Args a = a0; a.ph_lo = lo; a.ph_hi = hi;
    hipLaunchKernelGGL(mk_fwd, dim3(grid), dim3(NTHR), LDS_BYTES, stream, a, li, 0);
}
extern "C" void kernel_launch(void* const* d_in, const int* in_sizes, int n_in, void* d_out, int out_size, void* d_ws, size_t ws_size, hipStream_t stream) {
    static int grid = 0;
    if (grid == 0) {
        if (n_in != 16 || in_sizes[0] != T * D || out_size != T * D || ws_size < WS_END) { fprintf(stderr, "kernel_launch: unexpected shapes n_in %d in0 %d out %d ws %zu (need %zu)\n", n_in, n_in > 0 ? in_sizes[0] : -1, out_size, ws_size, (size_t)WS_END); grid = -1; return; }
        int dev = 0, cus = 0;
        if (hipGetDevice(&dev) != hipSuccess || hipDeviceGetAttribute(&cus, hipDeviceAttributeMultiprocessorCount, dev) != hipSuccess) { grid = -1; return; }
        if (hipFuncSetAttribute((const void*)mk_fwd, hipFuncAttributeMaxDynamicSharedMemorySize, LDS_BYTES) != hipSuccess) { fprintf(stderr, "kernel_launch: hipFuncSetAttribute failed\n"); grid = -1; return; }
        int per_cu = 0;
        if (hipOccupancyMaxActiveBlocksPerMultiprocessor(&per_cu, (const void*)mk_fwd, NTHR, LDS_BYTES) != hipSuccess || per_cu < 1) { fprintf(stderr, "kernel_launch: occupancy query says %d blocks/CU\n", per_cu); }
        (void)hipGetLastError();
        grid = cus;
    }
    if (grid < 0) return;
    unsigned char* ws = (unsigned char*)d_ws;
    (void)hipMemsetAsync(ws + WS_CTL, 0, CTL_BYTES, stream);
    Args a{};
    for (int i = 0; i < 16; ++i) a.in[i] = (const float*)d_in[i];
    a.out = (float*)d_out; a.ws = ws;
#if OPT_P2
    launch_mk(a, 0, NPH, 0, grid, stream);
#else
    launch_mk(a, 0, 2, 0, grid, stream);
    { bf16_t* proj = (bf16_t*)(ws + WS_PROJ); bf16_t* o = (bf16_t*)(ws + WS_XB);
      k_nret<<<T * RET_H / 4, 256, 0, stream>>>(proj, (const float*)d_in[2], o);
      k_nswa<<<T * SWA_H / 4, 256, 0, stream>>>(proj, (const float*)d_in[3], o); }
    launch_mk(a, 3, NPH, 1, grid, stream);
#endif
}
```

```cpp
#include <hip/hip_runtime.h>
#include <cstdio>
#include <cstdint>

typedef unsigned short bf16_t;
typedef float f32x4 __attribute__((ext_vector_type(4)));
typedef unsigned u32x4 __attribute__((ext_vector_type(4)));
typedef unsigned u32x2 __attribute__((ext_vector_type(2)));

constexpr int BATCH = 8, SEQ = 2048, D = 1024, T = BATCH * SEQ;
constexpr int RET_H = 4, RET_D = 128, RET_W = 512, CH = 128, NCH = SEQ / CH;
constexpr int SWA_H = 8, SWA_KV = 2, SWA_G = 4, SWA_D = 64, SWA_W = 512, SWA_KVW = 128, WIN = 128;
constexpr int INW = 2816;
constexpr int C_QR = 0, C_KR = 512, C_VR = 1024, C_GR = 1536, C_QA = 2048, C_KA = 2560, C_VA = 2688;
constexpr int NG = 4, EPG = 8, NE = 32, DE = 512;
constexpr float LN_EPS = 1e-5f, GN_EPS = 1e-6f;
constexpr float ALPHA = 1.189207115002721f;
constexpr float LOG2E = 1.4426950408889634f;
constexpr float QA_SCALE = 0.125f * LOG2E;
constexpr float KR_SCALE = 0.08838834764831845f;

constexpr size_t MiB = 1u << 20;
constexpr size_t WS_CTL = 0, CTL_BYTES = 64 * 1024;
constexpr size_t WS_WI = 1 * MiB;
constexpr size_t WS_WO = 7 * MiB;
constexpr size_t WS_WGU = 9 * MiB;
constexpr size_t WS_WD = 73 * MiB;
constexpr size_t WS_XB = 105 * MiB;
constexpr size_t WS_PROJ = 137 * MiB;
constexpr size_t WS_YS = 177 * MiB;
constexpr size_t WS_LIST = 257 * MiB;
constexpr size_t WS_TOK = 261 * MiB;
constexpr size_t WS_RW = 262 * MiB;
constexpr size_t WS_STATS = 200 * MiB;
constexpr size_t WS_END = 263 * MiB;
constexpr int LIST_CAP = 2 * T;
constexpr int MAX_SLOTS = 2 * T + NE * 256;
constexpr int CW_CNT = 0;
constexpr int CNT_STRIDE = 64;

__device__ __forceinline__ float bf2f(bf16_t b) { return __builtin_bit_cast(float, (unsigned)b << 16); }
__device__ __forceinline__ bf16_t f2bf(float f) { unsigned u = __builtin_bit_cast(unsigned, f); return (bf16_t)((u + 0x7fffu + ((u >> 16) & 1u)) >> 16); }
__device__ __forceinline__ unsigned pk2(float lo, float hi) { return (unsigned)f2bf(lo) | ((unsigned)f2bf(hi) << 16); }
__device__ __forceinline__ float wave_sum(float v) {
#pragma unroll
    for (int o = 1; o < 64; o <<= 1) v += __shfl_xor(v, o);
    return v;
}
__device__ __forceinline__ float log2gamma(int h) { return log2f(1.0f - exp2f(-5.0f - (float)h)); }
__device__ __forceinline__ float siluf(float v) { return v / (1.0f + __expf(-v)); }

#define LAS __attribute__((address_space(3)))
#define GAS __attribute__((address_space(1)))
typedef short bf16x8 __attribute__((ext_vector_type(8)));
constexpr int NWAVES = 8, NTHR = 512;
constexpr int RING_OFF = 0, RING_BYTES = 131072;
constexpr int LDS_BYTES = 163840;
constexpr int LDSCTL_OFF = 148736;
constexpr int MISC_OFF = LDSCTL_OFF;
constexpr int TB_OFF = LDSCTL_OFF + 128;
constexpr int P4H_OFF = LDSCTL_OFF + 384;
constexpr int P4PL_OFF = LDSCTL_OFF + 2688;
constexpr int GTAB_OFF = LDSCTL_OFF + 2688;
static_assert(P4PL_OFF + 64 * 36 * 4 <= LDS_BYTES && GTAB_OFF + 4 * 256 * 4 <= LDS_BYTES, "LDS map");
constexpr int P4_GSTRIDE = 4096 + 32;
static_assert(36 * P4_GSTRIDE <= LDSCTL_OFF, "P4 G image");
constexpr int CW_TMO = 3000;
constexpr int CW_BAR = 4096;
static_assert((CW_BAR + 3456) * 4 <= (int)CTL_BYTES, "ctl");

namespace pg8 {
constexpr int BM = 256, BK = 64, HALF = 128, HTB = HALF * BK * 2, STAGE_BYTES = 8 * HTB, NXCD = 8, WGM = 8;
__host__ __device__ __forceinline__ int lds_byte(int r, int c) { const int st = (r >> 4) * 2 + (c >> 5), rr = r & 15, cc = c & 31, ob = rr * 64 + cc * 2; return st * 1024 + (ob ^ (((ob >> 9) & 1) << 5)); }
__host__ __device__ __forceinline__ void stage_rc(int b, int& R, int& C) { const int st = b / 1024, sb = b % 1024, swz = sb ^ (((sb >> 9) & 1) << 5); R = (st >> 1) * 16 + swz / 64; C = (st & 1) * 32 + (swz % 64) / 2; }
__host__ __device__ __forceinline__ int perm32(int rho) { const int n = rho >> 4, i = rho & 15; return 8 * (i >> 2) + 4 * n + (i & 3); }
struct Unit { int pm, pn, e, ui; };

__device__ __forceinline__ unsigned cvt_pk_bf16(float lo, float hi) { unsigned r; asm volatile("v_cvt_pk_bf16_f32 %0, %1, %2" : "=v"(r) : "v"(lo), "v"(hi)); return r; }

__device__ __forceinline__ int xcd_remap(int L, int nwg) { const int q = nwg / NXCD, r = nwg % NXCD, xcd = L % NXCD, off = L / NXCD; return (xcd < r ? xcd * (q + 1) : r * (q + 1) + (xcd - r) * q) + off; }

struct DenseOrder {
    static constexpr bool GATHER = false;
    const bf16_t* A; const bf16_t* Bt; int K; int nM, nN, nwg, G, c;
    __device__ void init(const bf16_t* A_, const bf16_t* Bt_, int M, int N, int K_, int G_, int c_) { A = A_; Bt = Bt_; K = K_; nM = M / BM; nN = N / BM; nwg = nM * nN; G = G_; c = c_; }
    __device__ bool next(int i, Unit& u) const {
        const long L = (long)i * G + c; if (L >= nwg) return false;
        const int wgid = xcd_remap((int)L, nwg);
        const int nig = WGM * nN, gid = wgid / nig, fm = gid * WGM, gsz = (nM - fm) < WGM ? (nM - fm) : WGM;
        u.pm = fm + ((wgid % nig) % gsz); u.pn = (wgid % nig) / gsz; u.e = 0; u.ui = i; return true;
    }
    __device__ __forceinline__ const char* a_base(const Unit& u) const { return (const char*)A + (size_t)u.pm * (2 * HALF) * K * 2; }
    __device__ __forceinline__ const char* b_base(const Unit& u) const { return (const char*)Bt + (size_t)u.pn * (2 * HALF) * K * 2; }
    __device__ __forceinline__ unsigned goff(const Unit&, int) const { return 0u; }
};
struct MoeOrder {
    const bf16_t* A; const bf16_t* W; int K; int nN; size_t wstride  ; const LAS int* tb; const LAS unsigned* gtab; int nwg, G, c; bool gather;
    __device__ bool next(int i, Unit& u) const {
        const long L = (long)i * G + c; if (L >= nwg) return false;
        const int wgid = xcd_remap((int)L, nwg);
        u.pm = wgid / nN; u.pn = wgid % nN; u.ui = i;
        const int q = threadIdx.x & 31;
        const bool p = (q >= 1) && (tb[q] <= u.pm);
        u.e = __builtin_popcountll(__ballot(p) & 0xffffffffull); return true;
    }
    __device__ __forceinline__ const char* b_base(const Unit& u) const { return (const char*)W + ((size_t)u.e * wstride + (size_t)u.pn * (2 * HALF) * K) * 2; }
};
struct MoeGatherOrder : MoeOrder {
    static constexpr bool GATHER = true;
    __device__ __forceinline__ const char* a_base(const Unit&) const { return (const char*)A; }
    __device__ __forceinline__ unsigned goff(const Unit& u, int row) const { return gtab[(u.ui & 3) * 256 + row]; }
};
struct MoeDenseOrder : MoeOrder {
    static constexpr bool GATHER = false;
    __device__ __forceinline__ const char* a_base(const Unit& u) const { return (const char*)A + (size_t)u.pm * (2 * HALF) * K * 2; }
    __device__ __forceinline__ unsigned goff(const Unit&, int) const { return 0u; }
};

struct EpiProjF {
    static constexpr bool PERM = true;
    bf16_t* P;
    __device__ __forceinline__ void operator()(const f32x4 (&acc)[2][2][4][2], const Unit& u, int wr, int wc, int fr, int fq) const {
        const int row0 = u.pm * BM + wr * 64 + fr, col0 = u.pn * BM + wc * 32 + 8 * fq;
#pragma unroll
        for (int bj = 0; bj < 2; ++bj) {
            const int cb = u.pn * BM + bj * HALF;
            int kind = 0; float lg = 0.f;
            if (cb < C_KR) { kind = 1; lg = log2gamma(cb >> 7); } else if (cb < C_VR) { kind = 2; lg = log2gamma((cb - C_KR) >> 7); } else if (cb >= C_QA && cb < C_KA) kind = 3;
#pragma unroll
            for (int ai = 0; ai < 2; ++ai)
#pragma unroll
                for (int m = 0; m < 4; ++m) { const int row = row0 + ai * HALF + m * 16, i = row & (CH - 1);
                    float sc = 1.0f;
                    if (kind == 1) sc = exp2f(lg * (float)(i + 1)); else if (kind == 2) sc = KR_SCALE * exp2f(lg * (float)(CH - 1 - i)); else if (kind == 3) sc = QA_SCALE;
                    const f32x4 v0 = acc[ai][bj][m][0] * sc, v1 = acc[ai][bj][m][1] * sc;
                    u32x4 w; w.x = cvt_pk_bf16(v0[0], v0[1]); w.y = cvt_pk_bf16(v0[2], v0[3]); w.z = cvt_pk_bf16(v1[0], v1[1]); w.w = cvt_pk_bf16(v1[2], v1[3]);
                    *(u32x4*)(P + (size_t)row * INW + col0 + bj * HALF) = w; }
        }
    }
};
struct EpiZF {
    static constexpr bool PERM = false;
    const float* x; float* z; float* stats;
    __device__ __forceinline__ void operator()(const f32x4 (&acc)[2][2][4][2], const Unit& u, int wr, int wc, int fr, int fq) const {
        const int row0 = u.pm * BM + wr * 64 + fr, col0 = u.pn * BM + wc * 32 + 4 * fq;
#pragma unroll
        for (int ai = 0; ai < 2; ++ai)
#pragma unroll
            for (int m = 0; m < 4; ++m) { const int row = row0 + ai * HALF + m * 16; const size_t off = (size_t)row * D + col0; float s1 = 0.f, s2 = 0.f;
#pragma unroll
                for (int bj = 0; bj < 2; ++bj)
#pragma unroll
                    for (int n = 0; n < 2; ++n) { const f32x4 xv = *(const f32x4*)(x + off + bj * HALF + n * 16); const f32x4 zv = xv * ALPHA + acc[ai][bj][m][n]; *(f32x4*)(z + off + bj * HALF + n * 16) = zv;
                        s1 += (zv[0] + zv[1]) + (zv[2] + zv[3]); s2 += (zv[0] * zv[0] + zv[1] * zv[1]) + (zv[2] * zv[2] + zv[3] * zv[3]); }
                s1 += __shfl_xor(s1, 16); s2 += __shfl_xor(s2, 16); s1 += __shfl_xor(s1, 32); s2 += __shfl_xor(s2, 32);
                if (fq == 0) { typedef float f32x2v __attribute__((ext_vector_type(2))); *(f32x2v*)(stats + ((size_t)row * 16 + u.pn * 4 + wc) * 2) = (f32x2v){s1, s2}; } }
    }
};
struct EpiActF {
    static constexpr bool PERM = true;
    bf16_t* act;
    __device__ __forceinline__ void operator()(const f32x4 (&acc)[2][2][4][2], const Unit& u, int wr, int wc, int fr, int fq) const {
        const int row0 = u.pm * BM + wr * 64 + fr, col0 = u.pn * HALF + wc * 32 + 8 * fq;
#pragma unroll
        for (int ai = 0; ai < 2; ++ai)
#pragma unroll
            for (int m = 0; m < 4; ++m) { const int row = row0 + ai * HALF + m * 16;
                float r[8];
#pragma unroll
                for (int n = 0; n < 2; ++n)
#pragma unroll
                    for (int j = 0; j < 4; ++j) { const float g = acc[ai][0][m][n][j], up = acc[ai][1][m][n][j]; r[n * 4 + j] = g * up * __builtin_amdgcn_rcpf(1.0f + __expf(-g)); }
                u32x4 w; w.x = cvt_pk_bf16(r[0], r[1]); w.y = cvt_pk_bf16(r[2], r[3]); w.z = cvt_pk_bf16(r[4], r[5]); w.w = cvt_pk_bf16(r[6], r[7]);
                *(u32x4*)(act + (size_t)row * DE + col0) = w; }
    }
};
struct EpiYsF {
    static constexpr bool PERM = true;
    bf16_t* ys;
    __device__ __forceinline__ void operator()(const f32x4 (&acc)[2][2][4][2], const Unit& u, int wr, int wc, int fr, int fq) const {
        const int row0 = u.pm * BM + wr * 64 + fr, col0 = u.pn * BM + wc * 32 + 8 * fq;
#pragma unroll
        for (int ai = 0; ai < 2; ++ai)
#pragma unroll
            for (int m = 0; m < 4; ++m) { const int row = row0 + ai * HALF + m * 16;
#pragma unroll
                for (int bj = 0; bj < 2; ++bj) { const f32x4 v0 = acc[ai][bj][m][0], v1 = acc[ai][bj][m][1];
                    u32x4 w; w.x = cvt_pk_bf16(v0[0], v0[1]); w.y = cvt_pk_bf16(v0[2], v0[3]); w.z = cvt_pk_bf16(v1[0], v1[1]); w.w = cvt_pk_bf16(v1[2], v1[3]);
                    *(u32x4*)(ys + (size_t)row * D + col0 + bj * HALF) = w; } }
    }
};

template <class Epi, class Sched, bool ALIGN_EPI>
__device__ __forceinline__ void gemm_phase(LAS unsigned char* lds, const Sched& S, const Epi& E) {
    constexpr bool GATHER = Sched::GATHER;
    const int tid = threadIdx.x, wid = __builtin_amdgcn_readfirstlane(tid >> 6), lane = tid & 63, wr = wid >> 2, wc = wid & 3, fr = lane & 15, fq = lane >> 4;
    const int K = S.K, nt = K / BK;
    unsigned voffA[2], voffB[2]; int RA[2];
    unsigned voffG[2][2];
#pragma unroll
    for (int i = 0; i < 2; ++i) { int R, C; stage_rc(tid * 16 + i * 8192, R, C); const int Rb = Epi::PERM ? ((R & ~31) + perm32(R & 31)) : R;
        RA[i] = R; voffA[i] = GATHER ? (unsigned)(C * 2) : (unsigned)(R * K + C) * 2u; voffB[i] = (unsigned)(Rb * K + C) * 2u; }
    const size_t kstep = (size_t)(BK * 2);
    const size_t hstep = (size_t)HALF * K * 2;
    const unsigned ldsw = (unsigned)wid * 1024u;
    const int aoff = lds_byte(wr * 64 + fr, fq * 8), boff = lds_byte(wc * 32 + fr, fq * 8);
#define PG8_SA(b, h) (((b) * 2 + (h)) * HTB)
#define PG8_SB(b, h) ((4 + (b) * 2 + (h)) * HTB)
#define PG8_STAGE_B(bufoff, gbase, h) do { _Pragma("unroll") for (int _i = 0; _i < 2; ++_i) \
        __builtin_amdgcn_global_load_lds((const unsigned*)((const char*)(gbase) + (h) * hstep + voffB[_i]), (LAS unsigned*)(lds + (bufoff) + ldsw + _i * 8192), 16, 0, 0); } while (0)
#define PG8_STAGE_A(bufoff, gbase, h) do { _Pragma("unroll") for (int _i = 0; _i < 2; ++_i) \
        __builtin_amdgcn_global_load_lds((const unsigned*)((const char*)(gbase) + (GATHER ? (size_t)voffG[h][_i] : (h) * hstep + voffA[_i])), (LAS unsigned*)(lds + (bufoff) + ldsw + _i * 8192), 16, 0, 0); } while (0)
#define PG8_LDA(dst, b, h) do { _Pragma("unroll") for (int m = 0; m < 4; ++m) _Pragma("unroll") for (int k = 0; k < 2; ++k) dst[m][k] = *(const LAS bf16x8*)(lds + PG8_SA(b, h) + aoff + m * 2048 + k * 1024); } while (0)
#define PG8_LDB(dst, b, h) do { _Pragma("unroll") for (int n = 0; n < 2; ++n) _Pragma("unroll") for (int k = 0; k < 2; ++k) dst[n][k] = *(const LAS bf16x8*)(lds + PG8_SB(b, h) + boff + n * 2048 + k * 1024); } while (0)
#define PG8_MMA(ai, bj, At, Bt) do { __builtin_amdgcn_s_setprio(1); _Pragma("unroll") for (int m = 0; m < 4; ++m) _Pragma("unroll") for (int n = 0; n < 2; ++n) _Pragma("unroll") for (int k = 0; k < 2; ++k) \
        acc[ai][bj][m][n] = __builtin_amdgcn_mfma_f32_16x16x32_bf16(Bt[n][k], At[m][k], acc[ai][bj][m][n], 0, 0, 0); __builtin_amdgcn_s_setprio(0); } while (0)
#define PG8_WAIT_V(n) asm volatile("s_waitcnt vmcnt(" #n ")" ::: "memory")
#define PG8_WAIT_L(n) asm volatile("s_waitcnt lgkmcnt(" #n ")" ::: "memory")
#define PG8_BAR __builtin_amdgcn_s_barrier()
#define PG8_SCHED __builtin_amdgcn_sched_barrier(0)
#define PG8_GOFF(u) do { if (GATHER) { _Pragma("unroll") for (int _h = 0; _h < 2; ++_h) _Pragma("unroll") for (int _i = 0; _i < 2; ++_i) voffG[_h][_i] = S.goff(u, _h * HALF + RA[_i]) + voffA[_i]; } } while (0)
    Unit cur, nxt; int ui = 0;
    if (!S.next(0, cur)) return;
    f32x4 acc[2][2][4][2];
#pragma unroll
    for (int a = 0; a < 2; ++a)
#pragma unroll
        for (int b = 0; b < 2; ++b)
#pragma unroll
            for (int m = 0; m < 4; ++m)
#pragma unroll
                for (int n = 0; n < 2; ++n) acc[a][b][m][n] = (f32x4){0.f, 0.f, 0.f, 0.f};
    bf16x8 At[4][2], B0[2][2], B1[2][2];
    const char* cA = S.a_base(cur); const char* cB = S.b_base(cur);
    voffG[0][0] = voffG[0][1] = voffG[1][0] = voffG[1][1] = 0u;
    PG8_GOFF(cur);
    PG8_STAGE_B(PG8_SB(0, 0), cB, 0); PG8_STAGE_B(PG8_SB(0, 1), cB, 1); PG8_STAGE_A(PG8_SA(0, 0), cA, 0); PG8_STAGE_A(PG8_SA(0, 1), cA, 1);
    if (wr == 1) PG8_BAR;
    PG8_WAIT_V(2); PG8_BAR;
    PG8_STAGE_B(PG8_SB(1, 0), cB + kstep, 0); PG8_STAGE_A(PG8_SA(1, 0), cA + kstep, 0); PG8_STAGE_B(PG8_SB(1, 1), cB + kstep, 1);
    PG8_WAIT_V(6); PG8_BAR;
    for (;;) {
        const bool has_next = S.next(ui + 1, nxt);
        const char* nA = has_next ? S.a_base(nxt) : cA; const char* nB = has_next ? S.b_base(nxt) : cB;
        for (int t = 0; t < nt; t += 2) {
            const bool last = (t == nt - 2);
            const char* a1 = cA + (size_t)(t + 1) * kstep;
            const char* a2 = last ? nA : cA + (size_t)(t + 2) * kstep; const char* b2 = last ? nB : cB + (size_t)(t + 2) * kstep;
            const char* a3 = a2 + kstep; const char* b3 = b2 + kstep;
            PG8_LDB(B0, 0, 0); PG8_LDB(B1, 0, 1); PG8_SCHED; PG8_LDA(At, 0, 0); PG8_STAGE_A(PG8_SA(1, 1), a1, 1);
            if (GATHER) { if (last && has_next) PG8_GOFF(nxt); }
            PG8_WAIT_V(8); PG8_WAIT_L(0); PG8_BAR; PG8_MMA(0, 0, At, B0); PG8_MMA(0, 1, At, B1); PG8_BAR; PG8_SCHED;
            PG8_LDA(At, 0, 1); PG8_STAGE_B(PG8_SB(0, 0), b2, 0); PG8_STAGE_B(PG8_SB(0, 1), b2, 1); PG8_STAGE_A(PG8_SA(0, 0), a2, 0);
            PG8_WAIT_V(8); PG8_WAIT_L(0); PG8_BAR; PG8_MMA(1, 0, At, B0); PG8_MMA(1, 1, At, B1); PG8_BAR; PG8_SCHED;
            PG8_LDB(B0, 1, 0); PG8_LDB(B1, 1, 1); PG8_SCHED; PG8_LDA(At, 1, 0); PG8_STAGE_A(PG8_SA(0, 1), a2, 1);
            PG8_WAIT_V(8); PG8_WAIT_L(0); PG8_BAR; PG8_MMA(0, 0, At, B0); PG8_MMA(0, 1, At, B1); PG8_BAR; PG8_SCHED;
            PG8_LDA(At, 1, 1); PG8_STAGE_B(PG8_SB(1, 0), b3, 0); PG8_STAGE_B(PG8_SB(1, 1), b3, 1); PG8_STAGE_A(PG8_SA(1, 0), a3, 0);
            PG8_WAIT_V(8); PG8_WAIT_L(0); PG8_BAR; PG8_MMA(1, 0, At, B0); PG8_MMA(1, 1, At, B1); PG8_BAR; PG8_SCHED;
        }
        if constexpr (ALIGN_EPI) { if (wr == 0) PG8_BAR; }
        E(acc, cur, wr, wc, fr, fq);
        if (!has_next) break;
#pragma unroll
        for (int a = 0; a < 2; ++a)
#pragma unroll
            for (int b = 0; b < 2; ++b)
#pragma unroll
                for (int m = 0; m < 4; ++m)
#pragma unroll
                    for (int n = 0; n < 2; ++n) acc[a][b][m][n] = (f32x4){0.f, 0.f, 0.f, 0.f};
        cur = nxt; cA = nA; cB = nB; ++ui;
        if constexpr (ALIGN_EPI) { if (wr == 1) PG8_BAR; }
    }
    PG8_WAIT_V(0);
    if constexpr (!ALIGN_EPI) { if (wr == 0) PG8_BAR; }
    PG8_BAR;
#undef PG8_SA
#undef PG8_SB
#undef PG8_STAGE_A
#undef PG8_STAGE_B
#undef PG8_LDA
#undef PG8_LDB
#undef PG8_MMA
#undef PG8_WAIT_V
#undef PG8_WAIT_L
#undef PG8_BAR
#undef PG8_SCHED
#undef PG8_GOFF
}
}

typedef GAS unsigned gu32;
#define RLX_AGENT __ATOMIC_RELAXED, __HIP_MEMORY_SCOPE_AGENT
#define XB_TMO      128
#define XB_XCNT(j)  (256  + 64 * (j))
#define XB_XSUB(j)  (1280 + 64 * (j))
#define XB_XGEN(j)  (2304 + 64 * (j))
#define XB_TOP      3328
#define XB_TOPGEN   3392
#define XCD_BAR_WORDS 3456
#define XB_SPIN_CAP (1u << 18)
__device__ __forceinline__ unsigned xb_ld(unsigned* p)              { return __hip_atomic_load(p, __ATOMIC_RELAXED, __HIP_MEMORY_SCOPE_AGENT); }
__device__ __forceinline__ unsigned xb_add(unsigned* p, unsigned v) { return __hip_atomic_fetch_add(p, v, __ATOMIC_RELAXED, __HIP_MEMORY_SCOPE_AGENT); }
__device__ __forceinline__ unsigned xb_xcc_id() { return (unsigned)__builtin_amdgcn_s_getreg((3 << 11) | 20) & 0xFu; }
#define XB_SPIN(cond, bar) do { unsigned _sp = 0; while (cond) { __builtin_amdgcn_s_sleep(1); \
    if ((++_sp & 255u) == 0u) { if (xb_ld(&(bar)[XB_TMO])) break; if (_sp > XB_SPIN_CAP) { atomicAdd(&(bar)[XB_TMO], 1u); break; } } } } while (0)
struct XcdBarrier { unsigned* bar; unsigned x; volatile LAS unsigned* st; };
__device__ __forceinline__ XcdBarrier xcd_barrier_post(unsigned* bar, volatile LAS unsigned* st) {
    XcdBarrier b; b.bar = bar; b.x = xb_xcc_id(); b.st = st;
    if (threadIdx.x == 0) (void)xb_add(&bar[XB_XCNT(b.x)], 1u);
    return b;
}
__device__ __forceinline__ void xcd_barrier_complete(unsigned* bar, unsigned x, unsigned& nloc, unsigned& nx) {
    const unsigned G = gridDim.x * gridDim.y * gridDim.z;
    unsigned sum, cnt, mine, sp = 0u;
    for (;;) {
        sum = 0u; cnt = 0u; mine = 0u;
#pragma unroll
        for (unsigned j = 0; j < 16; ++j) { const unsigned c = xb_ld(&bar[XB_XCNT(j)]); sum += c; cnt += (c > 0u) ? 1u : 0u; mine = (j == x) ? c : mine; }
        if (sum == G) break;
        __builtin_amdgcn_s_sleep(1);
        if ((++sp & 255u) == 0u) { if (xb_ld(&bar[XB_TMO])) break; if (sp > XB_SPIN_CAP) { atomicAdd(&bar[XB_TMO], 1u); break; } }
    }
    nloc = mine > 0u ? mine : 1u; nx = cnt > 0u ? cnt : 1u;
}
__device__ __forceinline__ void xcd_barrier(const XcdBarrier& b) {
    asm volatile("s_waitcnt vmcnt(0)" ::: "memory");
    __syncthreads();
    if (threadIdx.x == 0) {
        unsigned* bar = b.bar;
        __builtin_amdgcn_s_waitcnt(0);
        unsigned nloc = b.st[0], nx = b.st[1];
        if (nloc == 0u) { xcd_barrier_complete(bar, b.x, nloc, nx); b.st[0] = nloc; b.st[1] = nx; }
        const unsigned old = xb_add(&bar[XB_XSUB(b.x)], 1u);
        const unsigned gen = old / nloc;
        if (old + 1u == (gen + 1u) * nloc) {
            __builtin_amdgcn_fence(__ATOMIC_RELEASE, "agent");
            asm volatile("s_waitcnt vmcnt(0)" ::: "memory");
            const unsigned og = xb_add(&bar[XB_TOP], 1u);
            const unsigned tg = og / nx;
            if (og + 1u == (tg + 1u) * nx) xb_add(&bar[XB_TOPGEN], 1u);
            else XB_SPIN(xb_ld(&bar[XB_TOPGEN]) == tg, bar);
            __builtin_amdgcn_fence(__ATOMIC_ACQUIRE, "agent");
            xb_add(&bar[XB_XGEN(b.x)], 1u);
            asm volatile("s_waitcnt vmcnt(0)" ::: "memory");
        } else {
            XB_SPIN(xb_ld(&bar[XB_XGEN(b.x)]) == gen, bar);
            __builtin_amdgcn_fence(__ATOMIC_ACQUIRE, "agent");
            asm volatile("s_waitcnt vmcnt(0)" ::: "memory");
        }
    }
    __syncthreads();
}

struct Frame {
    LAS unsigned char* lds; volatile LAS unsigned* MISC; unsigned* ctl;
    int tid, lane, wave, vcu, G;
};
struct Args { const float* in[16]; float* out; unsigned char* ws; int ph_lo, ph_hi; };

__device__ __forceinline__ void p0_transpose_item(const float* W, int K, int N, bf16_t* Wt, int kind, LAS float* scr, int item, int lane) {
    const int nblk = N / 32, kb = item / nblk, nb = item % nblk, k0 = 64 * kb, n0 = 32 * nb;
#pragma unroll 8
    for (int i = 0; i < 32; ++i) { const int kk = 2 * i + (lane >> 5); scr[kk * 33 + (lane & 31)] = W[(size_t)(k0 + kk) * N + n0 + (lane & 31)]; }
    asm volatile("s_waitcnt lgkmcnt(0)" ::: "memory");
    const int c = lane & 7;
#pragma unroll
    for (int j = 0; j < 4; ++j) { const int nn = (lane >> 3) + 8 * j; const LAS float* s = scr + (8 * c) * 33 + nn; const int n = n0 + nn;
        const int row = (kind == 0) ? n : ((n >> 7) * 256 + (kind - 1) * 128 + (n & 127));
        u32x4 o; o.x = pk2(s[0 * 33], s[1 * 33]); o.y = pk2(s[2 * 33], s[3 * 33]); o.z = pk2(s[4 * 33], s[5 * 33]); o.w = pk2(s[6 * 33], s[7 * 33]);
        *(u32x4*)(Wt + (size_t)row * K + k0 + 8 * c) = o; }
    asm volatile("s_waitcnt lgkmcnt(0)" ::: "memory");
}
__device__ __forceinline__ void convert_weights(Frame& F, const Args& a, int part) {
    unsigned char* ws = a.ws;
    LAS float* scr = (LAS float*)(F.lds + RING_OFF + F.wave * 16384);
    const int gw = F.vcu * NWAVES + F.wave, NGW = F.G * NWAVES;
    const float* w_in = a.in[1]; const float* w_out = a.in[4]; const float* w_gate = a.in[11]; const float* w_up = a.in[12]; const float* w_down = a.in[13];
    bf16_t* Wi = (bf16_t*)(ws + WS_WI); bf16_t* Wo = (bf16_t*)(ws + WS_WO); bf16_t* Wgu = (bf16_t*)(ws + WS_WGU); bf16_t* Wd = (bf16_t*)(ws + WS_WD);
    constexpr int I_IN = (D / 64) * (INW / 32), I_OUT = (D / 64) * (D / 32), I_G = (D / 64) * (DE / 32), I_D = (DE / 64) * (D / 32);
    if (part == 0) {
        for (int it = gw; it < I_IN + I_OUT; it += NGW) {
            if (it < I_IN) p0_transpose_item(w_in, D, INW, Wi, 0, scr, it, F.lane); else p0_transpose_item(w_out, D, D, Wo, 0, scr, it - I_IN, F.lane); }
    } else {
        for (int it = gw; it < NE * (2 * I_G + I_D); it += NGW) {
            const int e = it / (2 * I_G + I_D); int r = it - e * (2 * I_G + I_D);
            if (r < I_G) { p0_transpose_item(w_gate + (size_t)e * D * DE, D, DE, Wgu + (size_t)e * 1024 * D, 1, scr, r, F.lane); continue; } r -= I_G;
            if (r < I_G) { p0_transpose_item(w_up + (size_t)e * D * DE, D, DE, Wgu + (size_t)e * 1024 * D, 2, scr, r, F.lane); continue; } r -= I_G;
            p0_transpose_item(w_down + (size_t)e * DE * D, DE, D, Wd + (size_t)e * D * DE, 0, scr, r, F.lane);
        }
    }
}
__device__ __forceinline__ void p0_prologue(Frame& F, const Args& a) {
    unsigned char* ws = a.ws;
    const int gw = F.vcu * NWAVES + F.wave;
    convert_weights(F, a, 0);
    { const float* x = a.in[0]; bf16_t* xb = (bf16_t*)(ws + WS_XB); const size_t n4 = (size_t)T * D / 4;
      for (size_t i = (size_t)F.vcu * NTHR + F.tid; i < n4; i += (size_t)F.G * NTHR) { const f32x4 v = ((const f32x4*)x)[i]; u32x2 o; o.x = pk2(v.x, v.y); o.y = pk2(v.z, v.w); ((u32x2*)xb)[i] = o; } }
    { float* rw = (float*)(ws + WS_RW); const float* wgr = a.in[7]; const float* bgr = a.in[8]; const float* wer = a.in[9]; const float* ber = a.in[10]; const float* g1 = a.in[5]; const float* b1 = a.in[6];
      if (gw < 36) { const int cp = gw; float sg = 0.f, br = 0.f;
          for (int f = F.lane; f < D; f += 64) { const float r = (cp < 32) ? wer[((size_t)(cp >> 3) * D + f) * EPG + (cp & 7)] : wgr[f * NG + (cp - 32)];
              const float gm = g1[f] * r; rw[(size_t)cp * D + f] = gm; sg += gm; br += b1[f] * r; }
          sg = wave_sum(sg); br = wave_sum(br);
          if (F.lane == 0) { rw[36 * D + cp] = sg; rw[36 * D + 64 + cp] = br + ((cp < 32) ? ber[cp] : bgr[cp - 32]); } } }
}

__device__ __forceinline__ void p4_route(Frame& F, const Args& a) {
    unsigned char* ws = a.ws;
    const float* z = a.out; const float* g1 = a.in[5]; const float* b1 = a.in[6]; const float* rw = (const float*)(ws + WS_RW); const float* stats = (const float*)(ws + WS_STATS);
    bf16_t* hb = (bf16_t*)(ws + WS_XB); unsigned* cnt = F.ctl + CW_CNT; int* list = (int*)(ws + WS_LIST);
    int* tok_e = (int*)(ws + WS_TOK); int* tok_pos = tok_e + 2 * T; float* tok_w = (float*)(tok_pos + 2 * T);
    LAS unsigned* hist = (LAS unsigned*)(F.lds + P4H_OFF); LAS unsigned* base = hist + 32; LAS unsigned* rec = hist + 64; LAS float* PL = (LAS float*)(F.lds + P4PL_OFF);
    LAS unsigned char* Gl = F.lds;
    const int lane = F.lane, c16 = lane & 15, g4 = lane >> 4, blk = F.wave & 3, kh = F.wave >> 2;
    for (int i = F.tid; i < 36 * (D / 4); i += NTHR) { const int cp = i / (D / 4), f4 = i % (D / 4); *(LAS f32x4*)(Gl + cp * P4_GSTRIDE + f4 * 16) = *(const f32x4*)(rw + (size_t)cp * D + f4 * 4); }
    __syncthreads();
    const LAS unsigned char* gb0 = Gl + c16 * P4_GSTRIDE + g4 * 16; const LAS unsigned char* gb1 = gb0 + 16 * P4_GSTRIDE; const LAS unsigned char* gb2 = Gl + (32 + (c16 & 3)) * P4_GSTRIDE + g4 * 16;
    for (int grp = F.vcu; grp < T / 64; grp += F.G) {
        if (F.tid < 32) hist[F.tid] = 0u;
        const int tok = grp * 64 + blk * 16 + c16;
        float mean, rstd;
        { const f32x4 p0 = *(const f32x4*)(stats + ((size_t)tok * 16 + g4 * 4) * 2), p1 = *(const f32x4*)(stats + ((size_t)tok * 16 + g4 * 4) * 2 + 4);
          float s1 = (p0[0] + p0[2]) + (p1[0] + p1[2]), s2 = (p0[1] + p0[3]) + (p1[1] + p1[3]);
          s1 += __shfl_xor(s1, 16); s2 += __shfl_xor(s2, 16); s1 += __shfl_xor(s1, 32); s2 += __shfl_xor(s2, 32);
          mean = s1 * (1.f / D); const float var = fmaxf(s2 * (1.f / D) - mean * mean, 0.f); rstd = 1.0f / sqrtf(var + LN_EPS); }
        f32x4 acc0 = {0.f, 0.f, 0.f, 0.f}, acc1 = acc0, acc2 = acc0;
        const float* zr = z + (size_t)tok * D + kh * 512 + g4 * 4; bf16_t* hr = hb + (size_t)tok * D + kh * 512 + g4 * 4;
        const float* gr = g1 + kh * 512 + g4 * 4; const float* br = b1 + kh * 512 + g4 * 4; const int goff = kh * 2048;
#pragma unroll 8
        for (int sp = 0; sp < 32; ++sp) {
            const f32x4 zf = *(const f32x4*)(zr + sp * 16);
            const f32x4 gv = *(const f32x4*)(gr + sp * 16), bv = *(const f32x4*)(br + sp * 16);
            const f32x4 hv = (zf - mean) * rstd * gv + bv;
            u32x2 w; w.x = pk2(hv[0], hv[1]); w.y = pk2(hv[2], hv[3]); *(u32x2*)(hr + sp * 16) = w;
            const f32x4 G0 = *(const LAS f32x4*)(gb0 + goff + sp * 64), G1 = *(const LAS f32x4*)(gb1 + goff + sp * 64), G2 = *(const LAS f32x4*)(gb2 + goff + sp * 64);
#pragma unroll
            for (int i = 0; i < 4; ++i) { acc0 = __builtin_amdgcn_mfma_f32_16x16x4f32(zf[i], G0[i], acc0, 0, 0, 0); acc1 = __builtin_amdgcn_mfma_f32_16x16x4f32(zf[i], G1[i], acc1, 0, 0, 0);
                acc2 = __builtin_amdgcn_mfma_f32_16x16x4f32(zf[i], G2[i], acc2, 0, 0, 0); }
        }
        if (kh == 1) {
#pragma unroll
            for (int r = 0; r < 4; ++r) { LAS float* p = PL + (blk * 16 + g4 * 4 + r) * 36; p[c16] = acc0[r]; p[16 + c16] = acc1[r]; if (c16 < 4) p[32 + c16] = acc2[r]; }
        }
        __syncthreads();
        if (kh == 0) {
            const float sg0 = rw[36 * D + c16], sg1 = rw[36 * D + 16 + c16], sg2 = rw[36 * D + 32 + (c16 & 3)], br0 = rw[36 * D + 64 + c16], br1 = rw[36 * D + 64 + 16 + c16], br2 = rw[36 * D + 64 + 32 + (c16 & 3)];
#pragma unroll
            for (int r = 0; r < 4; ++r) { LAS float* p = PL + (blk * 16 + g4 * 4 + r) * 36; const float mt = __shfl(mean, g4 * 4 + r), rt = __shfl(rstd, g4 * 4 + r);
                const float l0 = rt * (acc0[r] + p[c16] - mt * sg0) + br0, l1 = rt * (acc1[r] + p[16 + c16] - mt * sg1) + br1, l2 = rt * (acc2[r] + p[32 + (c16 & 3)] - mt * sg2) + br2;
                p[c16] = l0; p[16 + c16] = l1; if (c16 < 4) p[32 + c16] = l2; }
        }
        __syncthreads();
        if (F.tid < 64) { const int lt = F.tid; const LAS float* p = PL + lt * 36;
            const float q0 = p[32], q1 = p[33], q2 = p[34], q3 = p[35];
            int gi = 0; float gm = q0;
            if (q1 > gm) { gm = q1; gi = 1; }
            if (q2 > gm) { gm = q2; gi = 2; }
            if (q3 > gm) { gm = q3; gi = 3; }
            const float gwt = 1.0f / (__expf(q0 - gm) + __expf(q1 - gm) + __expf(q2 - gm) + __expf(q3 - gm));
            float el[8];
#pragma unroll
            for (int e = 0; e < 8; ++e) el[e] = p[gi * 8 + e];
            int i0 = 0; float l0 = el[0];
#pragma unroll
            for (int e = 1; e < 8; ++e) if (el[e] > l0) { l0 = el[e]; i0 = e; }
            int i1 = -1; float l1 = -INFINITY;
#pragma unroll
            for (int e = 0; e < 8; ++e) if (e != i0 && el[e] > l1) { l1 = el[e]; i1 = e; }
            const float e1 = __expf(l1 - l0); const float w0 = gwt / (1.f + e1), w1 = gwt * e1 / (1.f + e1);
            const int e0 = gi * 8 + i0, e1i = gi * 8 + i1;
            const unsigned r0 = __hip_atomic_fetch_add(&hist[e0], 1u, __ATOMIC_RELAXED, __HIP_MEMORY_SCOPE_WORKGROUP), r1 = __hip_atomic_fetch_add(&hist[e1i], 1u, __ATOMIC_RELAXED, __HIP_MEMORY_SCOPE_WORKGROUP);
            rec[lt * 8 + 0] = (unsigned)e0; rec[lt * 8 + 1] = (unsigned)e1i; rec[lt * 8 + 2] = r0; rec[lt * 8 + 3] = r1;
            rec[lt * 8 + 4] = __float_as_uint(w0); rec[lt * 8 + 5] = __float_as_uint(w1);
        }
        __syncthreads();
        if (F.tid < 32) { const unsigned h = hist[F.tid]; base[F.tid] = h ? atomicAdd(&cnt[F.tid * CNT_STRIDE], h) : 0u; }
        __syncthreads();
        if (F.tid < 64) { const int lt = F.tid, tk = grp * 64 + lt;
            const int e0 = (int)rec[lt * 8 + 0], e1i = (int)rec[lt * 8 + 1];
            const int p0 = (int)(base[e0] + rec[lt * 8 + 2]), p1 = (int)(base[e1i] + rec[lt * 8 + 3]);
            list[(size_t)e0 * LIST_CAP + p0] = tk; list[(size_t)e1i * LIST_CAP + p1] = tk;
            tok_e[tk * 2] = e0; tok_e[tk * 2 + 1] = e1i; tok_pos[tk * 2] = p0; tok_pos[tk * 2 + 1] = p1;
            tok_w[tk * 2] = __uint_as_float(rec[lt * 8 + 4]); tok_w[tk * 2 + 1] = __uint_as_float(rec[lt * 8 + 5]); }
        __syncthreads();
    }
}
__device__ __forceinline__ void moe_setup(Frame& F) {
    LAS int* tb = (LAS int*)(F.lds + TB_OFF);
    if (F.wave == 0) { const int lane = F.lane;
        int c = lane < NE ? (((int)__hip_atomic_load(F.ctl + CW_CNT + (lane & 31) * CNT_STRIDE, RLX_AGENT) + 255) >> 8) : 0;
        int s = c;
#pragma unroll
        for (int o = 1; o < 32; o <<= 1) { const int t = __shfl_up(s, o); if (lane >= o) s += t; }
        if (lane < NE) tb[lane + 1] = s;
        if (lane == 0) tb[0] = 0; }
    asm volatile("s_waitcnt vmcnt(0) lgkmcnt(0)" ::: "memory"); __syncthreads();
}
__device__ __forceinline__ void p7_final(Frame& F, const Args& a) {
    unsigned char* ws = a.ws;
    const bf16_t* hb = (const bf16_t*)(ws + WS_XB); const bf16_t* ys = (const bf16_t*)(ws + WS_YS);
    const int* tok_e = (const int*)(ws + WS_TOK); const int* tok_pos = tok_e + 2 * T; const float* tok_w = (const float*)(tok_pos + 2 * T);
    const float* g2 = a.in[14]; const float* b2 = a.in[15]; float* out = a.out;
    const LAS int* tb = (const LAS int*)(F.lds + TB_OFF);
    const int lane = F.lane;
    for (int tok = F.vcu * NWAVES + F.wave; tok < T; tok += F.G * NWAVES) {
        const int s0 = tb[tok_e[tok * 2]] * 256 + tok_pos[tok * 2], s1 = tb[tok_e[tok * 2 + 1]] * 256 + tok_pos[tok * 2 + 1];
        const float w0 = tok_w[tok * 2], w1 = tok_w[tok * 2 + 1];
        f32x4 v[4]; float s = 0.f;
#pragma unroll
        for (int j = 0; j < 4; ++j) { const int c = j * 256 + lane * 4;
            const u32x2 hv = *(const u32x2*)(hb + (size_t)tok * D + c), y0 = *(const u32x2*)(ys + (size_t)s0 * D + c), y1 = *(const u32x2*)(ys + (size_t)s1 * D + c);
            v[j].x = ALPHA * bf2f((bf16_t)(hv.x & 0xffff)) + w0 * bf2f((bf16_t)(y0.x & 0xffff)) + w1 * bf2f((bf16_t)(y1.x & 0xffff));
            v[j].y = ALPHA * bf2f((bf16_t)(hv.x >> 16)) + w0 * bf2f((bf16_t)(y0.x >> 16)) + w1 * bf2f((bf16_t)(y1.x >> 16));
            v[j].z = ALPHA * bf2f((bf16_t)(hv.y & 0xffff)) + w0 * bf2f((bf16_t)(y0.y & 0xffff)) + w1 * bf2f((bf16_t)(y1.y & 0xffff));
            v[j].w = ALPHA * bf2f((bf16_t)(hv.y >> 16)) + w0 * bf2f((bf16_t)(y0.y >> 16)) + w1 * bf2f((bf16_t)(y1.y >> 16));
            s += (v[j].x + v[j].y) + (v[j].z + v[j].w); }
        const float mean = wave_sum(s) * (1.f / D); float s2 = 0.f;
#pragma unroll
        for (int j = 0; j < 4; ++j) { v[j] = v[j] - mean; s2 += (v[j].x * v[j].x + v[j].y * v[j].y) + (v[j].z * v[j].z + v[j].w * v[j].w); }
        const float rstd = 1.0f / sqrtf(wave_sum(s2) * (1.f / D) + LN_EPS);
#pragma unroll
        for (int j = 0; j < 4; ++j) { const int c = j * 256 + lane * 4; const f32x4 g = *(const f32x4*)(g2 + c), bb = *(const f32x4*)(b2 + c);
            *(f32x4*)(out + (size_t)tok * D + c) = v[j] * rstd * g + bb; }
    }
}
namespace att {
typedef float f32x16 __attribute__((ext_vector_type(16)));
typedef short s16x4 __attribute__((ext_vector_type(4)));
constexpr int TILE_B = 32768;
__device__ __forceinline__ int pc_row(int pc, int lane) { return 8 * (pc >> 1) + ((lane >> 2) & 7); }
__device__ __forceinline__ int pc_ch(int pc, int lane, int row) { return 8 * (pc & 1) + 4 * (lane >> 5) + ((lane & 3) ^ ((row >> 2) & 3)); }
__device__ __forceinline__ unsigned rr_base(int lane, int odd) { const int q31 = lane & 31, hi = lane >> 5; return 2048u * (q31 >> 3) + 64u * (q31 & 7) + 16u * ((unsigned)(2 * odd + hi) ^ ((q31 >> 2) & 3)); }
__device__ __forceinline__ unsigned tr_base(int lane, int t) { const int hi = lane >> 5, q = (lane & 15) >> 2, p = lane & 3, blk = (lane >> 4) & 1;
    return 2048u * t + 64u * (4 * hi + q) + 16u * ((unsigned)(2 * blk + (p >> 1)) ^ (unsigned)(2 * t + hi)) + 8u * (p & 1); }
__device__ __forceinline__ int crow(int r, int hi) { return (r & 3) + 8 * (r >> 2) + 4 * hi; }
__device__ __forceinline__ unsigned cvtpk(float lo, float hi) { typedef float f32x2_t __attribute__((ext_vector_type(2))); typedef __bf16 bf16x2_t __attribute__((ext_vector_type(2)));
    f32x2_t v = {lo, hi}; bf16x2_t b = __builtin_convertvector(v, bf16x2_t); return __builtin_bit_cast(unsigned, b); }
__device__ __forceinline__ s16x4 vtr(const LAS unsigned char* p) { return __builtin_bit_cast(s16x4, __builtin_amdgcn_ds_read_tr16_b64_v4i16((LAS s16x4*)p)); }
__device__ __forceinline__ float xhalf_sum(float v) { return v + __shfl_xor(v, 32); }
__device__ __forceinline__ float xhalf_max(float v) { return fmaxf(v, __shfl_xor(v, 32)); }
#define ATT_GLDS(src, dst) __builtin_amdgcn_global_load_lds((const unsigned*)(src), (LAS unsigned*)(dst), 16, 0, 0)

__device__ __forceinline__ void ret_load(LAS unsigned char* tile, const bf16_t* proj, int b, int h, int m, int wid, int lane) {
    const bf16_t* Kg = proj + (size_t)(b * SEQ + m * CH) * INW + C_KR + h * RET_D;
    const bf16_t* Vg = proj + (size_t)(b * SEQ + m * CH) * INW + C_VR + h * RET_D;
#pragma unroll
    for (int k = 0; k < 4; ++k) { const int pc = wid * 4 + k, row = pc_row(pc, lane), ch = pc_ch(pc, lane, row);
        ATT_GLDS(Kg + (size_t)row * INW + ch * 8, tile + pc * 1024);
        ATT_GLDS(Vg + (size_t)row * INW + ch * 8, tile + TILE_B + pc * 1024); }
}
__device__ __forceinline__ void swa_load(LAS unsigned char* tile, const bf16_t* proj, int b, int kvh, int n, int wid, int lane) {
#pragma unroll
    for (int k = 0; k < 4; ++k) { const int pc = wid * 4 + k, row = pc_row(pc, lane), ch = pc_ch(pc, lane, row);
        int t = (n - 1) * WIN + row + 128 * (ch >> 3); t = t < 0 ? 0 : t;
        const bf16_t* src = proj + (size_t)(b * SEQ + t) * INW + kvh * SWA_D + (ch & 7) * 8;
        ATT_GLDS(src + C_KA, tile + pc * 1024);
        ATT_GLDS(src + C_VA, tile + TILE_B + pc * 1024); }
}

__device__ __forceinline__ void ret_chunk(LAS unsigned char* ring, const bf16_t* proj, const float* gn_g, bf16_t* o, int b, int h, int n, int wid, int lane) {
    const int rb = wid & 3, kh = wid >> 2, q31 = lane & 31, hi = lane >> 5;
    const float lg = log2gamma(h);
    bf16x8 qf[8];
    { const bf16_t* Qg = proj + (size_t)(b * SEQ + n * CH + 32 * rb + q31) * INW + C_QR + h * RET_D + 8 * hi;
#pragma unroll
      for (int s = 0; s < 8; ++s) qf[s] = *(const bf16x8*)(Qg + 16 * s); }
    f32x16 O[4];
#pragma unroll
    for (int d = 0; d < 4; ++d) O[d] = f32x16{};
    const unsigned kb0 = rr_base(lane, 0) + 16384u * kh, kb1 = rr_base(lane, 1) + 16384u * kh, vb0 = tr_base(lane, 0) + 16384u * kh + TILE_B, vb1 = tr_base(lane, 1) + 16384u * kh + TILE_B;
    ret_load(ring, proj, b, h, 0, wid, lane);
    for (int m = 0; m <= n; ++m) {
        LAS unsigned char* Kt = ring + (m & 1) * 2 * TILE_B;
        const LAS unsigned char* K0 = Kt + kb0; const LAS unsigned char* K1 = Kt + kb1; const LAS unsigned char* V0 = Kt + vb0; const LAS unsigned char* V1 = Kt + vb1;
        asm volatile("s_waitcnt vmcnt(0)" ::: "memory"); __syncthreads();
        if (m < n) ret_load(ring + ((m + 1) & 1) * 2 * TILE_B, proj, b, h, m + 1, wid, lane);
        const bool diag = (m == n);
        const float c = exp2f(lg * (float)((n - m - 1) * CH));
#pragma unroll
        for (int kb = 0; kb < 2; ++kb) {
            const int key0 = 64 * kh + 32 * kb;
            if (diag && key0 > 32 * rb + 31) continue;
            f32x16 X = f32x16{};
#pragma unroll
            for (int s = 0; s < 8; ++s) { const bf16x8 kf = *(const LAS bf16x8*)(((s & 1) ? K1 : K0) + 8192 * kb + 512 * (s >> 1)); X = __builtin_amdgcn_mfma_f32_32x32x16_bf16(kf, qf[s], X, 0, 0, 0); }
#pragma unroll
            for (int r = 0; r < 16; ++r) { float v = X[r] * c; if (diag && (key0 + crow(r, hi) > 32 * rb + q31)) v = 0.f; X[r] = v; }
#pragma unroll
            for (int sp = 0; sp < 2; ++sp) {
                u32x4 pw; pw.x = cvtpk(X[8 * sp + 0], X[8 * sp + 1]); pw.y = cvtpk(X[8 * sp + 2], X[8 * sp + 3]); pw.z = cvtpk(X[8 * sp + 4], X[8 * sp + 5]); pw.w = cvtpk(X[8 * sp + 6], X[8 * sp + 7]);
                const bf16x8 pf = __builtin_bit_cast(bf16x8, pw);
#pragma unroll
                for (int d = 0; d < 4; ++d) {
                    const s16x4 lo = vtr(V0 + 8192 * kb + 4096 * sp + 512 * d);
                    const s16x4 hh = vtr(V1 + 8192 * kb + 4096 * sp + 512 * d);
                    const bf16x8 vf = (bf16x8){lo[0], lo[1], lo[2], lo[3], hh[0], hh[1], hh[2], hh[3]};
                    O[d] = __builtin_amdgcn_mfma_f32_32x32x16_bf16(vf, pf, O[d], 0, 0, 0);
                }
            }
        }
    }
    __syncthreads();
    LAS float* cs = (LAS float*)ring;
    if (kh == 1) {
#pragma unroll
        for (int d = 0; d < 4; ++d)
#pragma unroll
            for (int r = 0; r < 16; ++r) cs[((rb * 4 + d) * 16 + r) * 64 + lane] = O[d][r];
    }
    __syncthreads();
    if (kh == 0) {
#pragma unroll
        for (int d = 0; d < 4; ++d)
#pragma unroll
            for (int r = 0; r < 16; ++r) O[d][r] += cs[((rb * 4 + d) * 16 + r) * 64 + lane];
        float s = 0.f;
#pragma unroll
        for (int d = 0; d < 4; ++d)
#pragma unroll
            for (int r = 0; r < 16; ++r) s += O[d][r];
        const float mu = xhalf_sum(s) * (1.f / RET_D);
        float s2 = 0.f;
#pragma unroll
        for (int d = 0; d < 4; ++d)
#pragma unroll
            for (int r = 0; r < 16; ++r) { const float t = O[d][r] - mu; O[d][r] = t; s2 += t * t; }
        const float rs = 1.0f / sqrtf(xhalf_sum(s2) * (1.f / RET_D) + GN_EPS);
        const size_t tok = (size_t)(b * SEQ + n * CH + 32 * rb + q31);
        const bf16_t* gp = proj + tok * INW + C_GR + h * RET_D; bf16_t* op = o + tok * D + h * RET_D; const float* gg = gn_g + h * RET_D;
#pragma unroll
        for (int d = 0; d < 4; ++d)
#pragma unroll
            for (int r4 = 0; r4 < 4; ++r4) { const int dd = 32 * d + 8 * r4 + 4 * hi;
                const u32x2 gv = *(const u32x2*)(gp + dd); const f32x4 gw = *(const f32x4*)(gg + dd);
                const float g0 = bf2f((bf16_t)(gv.x & 0xffff)), g1 = bf2f((bf16_t)(gv.x >> 16)), g2 = bf2f((bf16_t)(gv.y & 0xffff)), g3 = bf2f((bf16_t)(gv.y >> 16));
                u32x2 w; w.x = cvtpk(O[d][4 * r4 + 0] * rs * gw.x * siluf(g0), O[d][4 * r4 + 1] * rs * gw.y * siluf(g1));
                w.y = cvtpk(O[d][4 * r4 + 2] * rs * gw.z * siluf(g2), O[d][4 * r4 + 3] * rs * gw.w * siluf(g3));
                *(u32x2*)(op + dd) = w; }
    }
    __syncthreads();
}

__device__ __forceinline__ void swa_unit(LAS unsigned char* ring, const bf16_t* proj, const float* sinks, bf16_t* o, int b, int kvh, int n, int wid, int lane) {
    const int q31 = lane & 31, hi = lane >> 5;
    const LAS unsigned char* K0 = ring + rr_base(lane, 0); const LAS unsigned char* K1 = ring + rr_base(lane, 1);
    const LAS unsigned char* V0 = ring + TILE_B + tr_base(lane, 0); const LAS unsigned char* V1 = ring + TILE_B + tr_base(lane, 1);
    swa_load(ring, proj, b, kvh, n, wid, lane);
    asm volatile("s_waitcnt vmcnt(0)" ::: "memory"); __syncthreads();
    const int g = wid >> 1, hq = kvh * SWA_G + g;
    const float slope2 = exp2f(-(float)(hq + 1)) * LOG2E, sink2 = sinks[hq] * LOG2E;
#pragma unroll 1
    for (int tk = 0; tk < 2; ++tk) {
        const int rb = 2 * (wid & 1) + tk;
        const int qi = 32 * rb + q31;
        const size_t tok = (size_t)(b * SEQ + n * WIN + qi);
        bf16x8 qf[4];
        { const bf16_t* Qg = proj + tok * INW + C_QA + hq * SWA_D + 8 * hi;
#pragma unroll
          for (int s = 0; s < 4; ++s) qf[s] = *(const bf16x8*)(Qg + 16 * s); }
        f32x16 X[5];
#pragma unroll
        for (int kk = 0; kk < 5; ++kk) { const int key0 = 32 * (rb + kk);
            const int boff = 8192 * ((key0 >> 5) & 3) + 1024 * (key0 >> 7);
            f32x16 x = f32x16{};
#pragma unroll
            for (int s = 0; s < 4; ++s) { const bf16x8 kf = *(const LAS bf16x8*)(((s & 1) ? K1 : K0) + boff + 512 * (s >> 1)); x = __builtin_amdgcn_mfma_f32_32x32x16_bf16(kf, qf[s], x, 0, 0, 0); }
            X[kk] = x; }
        float mx = sink2;
#pragma unroll
        for (int kk = 0; kk < 5; ++kk)
#pragma unroll
            for (int r = 0; r < 16; ++r) { const int j = 32 * (rb + kk) + crow(r, hi); const int dist = qi + WIN - j;
                const bool valid = (dist >= 0) && (dist < WIN) && (n > 0 || j >= WIN);
                const float v = valid ? X[kk][r] - slope2 * (float)dist : -INFINITY; X[kk][r] = v; mx = fmaxf(mx, v); }
        mx = xhalf_max(mx);
        float l = 0.f;
#pragma unroll
        for (int kk = 0; kk < 5; ++kk)
#pragma unroll
            for (int r = 0; r < 16; ++r) { const float p = exp2f(X[kk][r] - mx); X[kk][r] = p; l += p; }
        l = xhalf_sum(l) + exp2f(sink2 - mx);
        f32x16 O[2]; O[0] = f32x16{}; O[1] = f32x16{};
#pragma unroll
        for (int kk = 0; kk < 5; ++kk) { const int key0 = 32 * (rb + kk); const int boff = 8192 * ((key0 >> 5) & 3) + 1024 * (key0 >> 7);
#pragma unroll
            for (int sp = 0; sp < 2; ++sp) {
                u32x4 pw; pw.x = cvtpk(X[kk][8 * sp + 0], X[kk][8 * sp + 1]); pw.y = cvtpk(X[kk][8 * sp + 2], X[kk][8 * sp + 3]); pw.z = cvtpk(X[kk][8 * sp + 4], X[kk][8 * sp + 5]); pw.w = cvtpk(X[kk][8 * sp + 6], X[kk][8 * sp + 7]);
                const bf16x8 pf = __builtin_bit_cast(bf16x8, pw);
#pragma unroll
                for (int d = 0; d < 2; ++d) {
                    const s16x4 lo = vtr(V0 + boff + 4096 * sp + 512 * d);
                    const s16x4 hh = vtr(V1 + boff + 4096 * sp + 512 * d);
                    const bf16x8 vf = (bf16x8){lo[0], lo[1], lo[2], lo[3], hh[0], hh[1], hh[2], hh[3]};
                    O[d] = __builtin_amdgcn_mfma_f32_32x32x16_bf16(vf, pf, O[d], 0, 0, 0);
                }
            } }
        const float rl = 1.0f / l;
        bf16_t* op = o + tok * D + RET_W + hq * SWA_D;
#pragma unroll
        for (int d = 0; d < 2; ++d)
#pragma unroll
            for (int r4 = 0; r4 < 4; ++r4) { const int dd = 32 * d + 8 * r4 + 4 * hi;
                u32x2 w; w.x = cvtpk(O[d][4 * r4 + 0] * rl, O[d][4 * r4 + 1] * rl); w.y = cvtpk(O[d][4 * r4 + 2] * rl, O[d][4 * r4 + 3] * rl);
                *(u32x2*)(op + dd) = w; }
    }
    __syncthreads();
}
#undef ATT_GLDS
}

__device__ __forceinline__ void p2_attention(Frame& F, const Args& a) {
    unsigned char* ws = a.ws;
    const bf16_t* proj = (const bf16_t*)(ws + WS_PROJ); bf16_t* o = (bf16_t*)(ws + WS_XB);
    LAS unsigned char* ring = F.lds + RING_OFF;
    for (int it = F.vcu; it < BATCH * RET_H * (NCH / 2); it += F.G) {
        const int b = it / (RET_H * (NCH / 2)), h = (it / (NCH / 2)) % RET_H, j = it % (NCH / 2);
        att::ret_chunk(ring, proj, a.in[2], o, b, h, NCH - 1 - j, F.wave, F.lane);
        att::ret_chunk(ring, proj, a.in[2], o, b, h, j, F.wave, F.lane);
    }
    for (int it = F.vcu; it < BATCH * SWA_KV * (SEQ / WIN); it += F.G) {
        const int b = it / (SWA_KV * (SEQ / WIN)), kvh = (it / (SEQ / WIN)) % SWA_KV, n = it % (SEQ / WIN);
        att::swa_unit(ring, proj, a.in[3], o, b, kvh, n, F.wave, F.lane);
    }
}
constexpr int NPH = 8;
#ifndef REP_PH
#define REP_PH -1
#endif
#define REPN(k) ((REP_PH == (k)) ? 2 : 1)
#ifndef OPT_P2
#define OPT_P2 0
#endif
__global__ void __launch_bounds__(NTHR, 2) mk_fwd(Args args, int li, int pad) {
    extern __shared__ __attribute__((aligned(16))) unsigned char lds_raw[];
    Frame F;
    F.lds = (LAS unsigned char*)lds_raw;
    F.MISC = (volatile LAS unsigned*)(F.lds + MISC_OFF);
    F.tid = threadIdx.x; F.lane = F.tid & 63; F.wave = __builtin_amdgcn_readfirstlane(F.tid >> 6);
    F.G = gridDim.x; { const int bx = blockIdx.x; F.vcu = (F.G % 8 == 0) ? (bx % 8) * (F.G / 8) + bx / 8 : bx; }
    unsigned char* ws = args.ws;
    F.ctl = (unsigned*)(ws + WS_CTL);
    for (int u = F.tid; u < (LDS_BYTES - LDSCTL_OFF) / 4; u += NTHR) ((LAS unsigned*)(F.lds + LDSCTL_OFF))[u] = 0u;
    __syncthreads();
    const int lo = args.ph_lo, hi = args.ph_hi;
    XcdBarrier bar; bar.bar = F.ctl + CW_BAR + li * XCD_BAR_WORDS; bar.x = 0; bar.st = nullptr;
    if (hi - lo > 1) bar = xcd_barrier_post(F.ctl + CW_BAR + li * XCD_BAR_WORDS, F.MISC + 8);
#define IN(k) (lo <= (k) && (k) < hi)
#define BOTH(k) (IN(k) && IN((k) + 1))
#if defined(PROBE_TS_A)
    unsigned long long ts_prev = __builtin_amdgcn_s_memrealtime(); float ts_a = 0.f, ts_b = 0.f; int ts_ph = 0;
#define GRID_BAR() do { xcd_barrier(bar); { const unsigned long long t_ = __builtin_amdgcn_s_memrealtime(); const float d_ = (float)(t_ - ts_prev) * 0.01f; ts_prev = t_; \
        if (ts_ph == PROBE_TS_A) ts_a = 8.0f * rintf(d_ * 0.125f); if (ts_ph == PROBE_TS_B) ts_b = 8.0f * rintf(d_ * 0.125f); ++ts_ph; } } while (0)
#else
#define GRID_BAR() xcd_barrier(bar)
#endif
    bf16_t* Wi = (bf16_t*)(ws + WS_WI); bf16_t* Wo = (bf16_t*)(ws + WS_WO); bf16_t* Wgu = (bf16_t*)(ws + WS_WGU); bf16_t* Wd = (bf16_t*)(ws + WS_WD);
    bf16_t* xb = (bf16_t*)(ws + WS_XB); bf16_t* proj = (bf16_t*)(ws + WS_PROJ); bf16_t* act = (bf16_t*)(ws + WS_PROJ); bf16_t* ys = (bf16_t*)(ws + WS_YS);

    if (IN(0)) { for (int rep = 0; rep < REPN(0); ++rep) { p0_prologue(F, args); if (BOTH(0)) GRID_BAR(); } }
    if (IN(1)) for (int rep = 0; rep < REPN(1); ++rep) {
        pg8::DenseOrder S; S.init(xb, Wi, T, INW, D, F.G, (int)blockIdx.x);
        pg8::EpiProjF E{proj};
        pg8::gemm_phase<pg8::EpiProjF, pg8::DenseOrder, true>(F.lds + RING_OFF, S, E);
        if (BOTH(1)) GRID_BAR();
    }
    if (IN(2)) for (int rep = 0; rep < REPN(2); ++rep) {
        p2_attention(F, args);
        if (BOTH(2)) GRID_BAR();
    }
    if (IN(3)) for (int rep = 0; rep < REPN(3); ++rep) {
        pg8::DenseOrder S; S.init(xb  , Wo, T, D, D, F.G, (int)blockIdx.x);
        pg8::EpiZF E{args.in[0], args.out, (float*)(ws + WS_STATS)};
        pg8::gemm_phase<pg8::EpiZF, pg8::DenseOrder, false>(F.lds + RING_OFF, S, E);
        if (BOTH(3)) GRID_BAR();
    }
    if (IN(4)) { p4_route(F, args); __syncthreads(); convert_weights(F, args, 1); if (BOTH(4)) GRID_BAR(); }
    if (IN(5)) for (int rep = 0; rep < REPN(5); ++rep) {
        moe_setup(F);
        const LAS int* tb = (const LAS int*)(F.lds + TB_OFF);
        LAS unsigned* gtab = (LAS unsigned*)(F.lds + GTAB_OFF);
        pg8::MoeGatherOrder S; S.A = xb  ; S.W = Wgu; S.K = D; S.nN = 4; S.wstride = (size_t)1024 * D; S.tb = tb; S.gtab = gtab; S.nwg = tb[NE] * 4; S.G = F.G; S.c = (int)blockIdx.x; S.gather = true;
        {
            const int* list = (const int*)(ws + WS_LIST);
            for (int idx = F.tid; idx < 4 * 256; idx += NTHR) { const int i = idx >> 8, r = idx & 255; pg8::Unit u;
                if (S.next(i, u)) { const int local = (u.pm - tb[u.e]) * 256 + r; const int c = (int)__hip_atomic_load(F.ctl + CW_CNT + u.e * CNT_STRIDE, RLX_AGENT);
                    const int tok = list[(size_t)u.e * LIST_CAP + (local < c ? local : 0)]; gtab[i * 256 + r] = (unsigned)tok * (unsigned)(D * 2); } }
            asm volatile("s_waitcnt vmcnt(0) lgkmcnt(0)" ::: "memory"); __syncthreads();
        }
        pg8::EpiActF E{act};
        pg8::gemm_phase<pg8::EpiActF, pg8::MoeGatherOrder, true>(F.lds + RING_OFF, S, E);
        if (BOTH(5)) GRID_BAR();
    }
    if (IN(6)) for (int rep = 0; rep < REPN(6); ++rep) {
        moe_setup(F);
        const LAS int* tb = (const LAS int*)(F.lds + TB_OFF);
        pg8::MoeDenseOrder S; S.A = act; S.W = Wd; S.K = DE; S.nN = 4; S.wstride = (size_t)D * DE; S.tb = tb; S.gtab = nullptr; S.nwg = tb[NE] * 4; S.G = F.G; S.c = (int)blockIdx.x; S.gather = false;
        pg8::EpiYsF E{ys};
        pg8::gemm_phase<pg8::EpiYsF, pg8::MoeDenseOrder, true>(F.lds + RING_OFF, S, E);
#if defined(PROBE_TS_A)
        if (blockIdx.x == 0 && F.tid == 0) { __hip_atomic_store((float*)(F.ctl + 3100), ts_a, RLX_AGENT); __hip_atomic_store((float*)(F.ctl + 3101), ts_b, RLX_AGENT); }
#endif
        if (BOTH(6)) GRID_BAR();
    }
    if (IN(7)) for (int rep = 0; rep < REPN(7); ++rep) { moe_setup(F); p7_final(F, args); if (rep + 1 < REPN(7)) GRID_BAR(); }
#if defined(PROBE_TS_A)
    {
        const float sc = 1.0f + __hip_atomic_load((float*)(F.ctl + 3100), RLX_AGENT) * 0.001f; const float spike = __hip_atomic_load((float*)(F.ctl + 3101), RLX_AGENT) * 0.25f;
        asm volatile("s_waitcnt vmcnt(0)" ::: "memory"); __syncthreads();
        for (int tok = F.vcu * NWAVES + F.wave; tok < T; tok += F.G * NWAVES) { for (int j = 0; j < 4; ++j) { f32x4* p = (f32x4*)(args.out + (size_t)tok * D + j * 256 + F.lane * 4); f32x4 v = *p; v = v * sc; if (tok == 0 && j == 0 && F.lane == 0) v[0] += spike; *p = v; } }
    }
#endif
#undef IN
#undef BOTH
#undef GRID_BAR
}

static void launch_mk(const Args& a0, int lo, int hi, int li, int grid, hipStream_t stream) {
    Args a = a0; a.ph_lo = lo; a.ph_hi = hi;
    hipLaunchKernelGGL(mk_fwd, dim3(grid), dim3(NTHR), LDS_BYTES, stream, a, li, 0);
}
extern "C" void kernel_launch(void* const* d_in, const int* in_sizes, int n_in, void* d_out, int out_size, void* d_ws, size_t ws_size, hipStream_t stream) {
    static int grid = 0;
    if (grid == 0) {
        if (n_in != 16 || in_sizes[0] != T * D || out_size != T * D || ws_size < WS_END) { fprintf(stderr, "kernel_launch: unexpected shapes n_in %d in0 %d out %d ws %zu (need %zu)\n", n_in, n_in > 0 ? in_sizes[0] : -1, out_size, ws_size, (size_t)WS_END); grid = -1; return; }
        int dev = 0, cus = 0;
        if (hipGetDevice(&dev) != hipSuccess || hipDeviceGetAttribute(&cus, hipDeviceAttributeMultiprocessorCount, dev) != hipSuccess) { grid = -1; return; }
        if (hipFuncSetAttribute((const void*)mk_fwd, hipFuncAttributeMaxDynamicSharedMemorySize, LDS_BYTES) != hipSuccess) { fprintf(stderr, "kernel_launch: hipFuncSetAttribute failed\n"); grid = -1; return; }
        int per_cu = 0;
        if (hipOccupancyMaxActiveBlocksPerMultiprocessor(&per_cu, (const void*)mk_fwd, NTHR, LDS_BYTES) != hipSuccess || per_cu < 1) { fprintf(stderr, "kernel_launch: occupancy query says %d blocks/CU\n", per_cu); }
        (void)hipGetLastError();
        grid = cus;
    }
    if (grid < 0) return;
    unsigned char* ws = (unsigned char*)d_ws;
    (void)hipMemsetAsync(ws + WS_CTL, 0, CTL_BYTES, stream);
    Args a{};
    for (int i = 0; i < 16; ++i) a.in[i] = (const float*)d_in[i];
    a.out = (float*)d_out; a.ws = ws;
#if defined(PROBE_SPLIT)
    launch_mk(a, 0, PROBE_SPLIT + 1, 0, grid, stream);
    launch_mk(a, PROBE_SPLIT, PROBE_SPLIT + 1, 1, grid, stream);
    launch_mk(a, PROBE_SPLIT + 1, NPH, 2, grid, stream);
#else
    launch_mk(a, 0, NPH, 0, grid, stream);
#endif
}
```
